# Optimizing an MI355X kernel written in HIP

```python
import math
import jax
import jax.numpy as jnp
from jax import lax
import numpy as np

D_MODEL = 1024
BATCH = 1
SEQ = 16384
DEPTH = 1

GRID_W = 64
CTX_LEN = 256
MIX_W = D_MODEL
CONV_W = MIX_W // 2
CONV_HEADS = 8
SSM_W = MIX_W - CONV_W
SSM_GROUP = 16
SSM_GROUPS = SSM_W // SSM_GROUP
SSM_STATE = 64
IN_W = 3 * CONV_W + SSM_W
D_FF = 4 * D_MODEL
N_MOD = 6
RMS_EPS = 1e-6
DT_MIN = 1e-3
DT_MAX = 1e-1

kernel_name = 'hybrid_conv_s5_prefix_block'


def rms_norm(x, g):
    xf = x.astype(jnp.float32)
    y = xf * lax.rsqrt(jnp.mean(xf * xf, axis=-1, keepdims=True) + RMS_EPS)
    return (y * g.astype(jnp.float32)).astype(x.dtype)


def head_rms_norm(y, n_heads, g):
    shp = y.shape
    yh = y.reshape(shp[:-1] + (n_heads, shp[-1] // n_heads)).astype(jnp.float32)
    yh = yh * lax.rsqrt(jnp.mean(yh * yh, axis=-1, keepdims=True) + RMS_EPS)
    return (yh.reshape(shp) * g.astype(jnp.float32)).astype(y.dtype)


def short_conv(z, w):
    pad = [(0, 0)] * (z.ndim - 2) + [(1, 1), (0, 0)]
    zp = jnp.pad(z, pad)
    n = z.shape[-2]
    return w[0] * zp[..., 0:n, :] + w[1] * zp[..., 1:n + 1, :] + w[2] * zp[..., 2:n + 2, :]


def zoh(a_re, a_im, log_dt, b_re, b_im):
    dt = jnp.exp(log_dt)[:, None]
    lr = jnp.minimum(a_re, -1e-4)
    li = a_im
    mag = jnp.exp(lr * dt)
    ab_re = mag * jnp.cos(li * dt)
    ab_im = mag * jnp.sin(li * dt)
    nr = ab_re - 1.0
    den = lr * lr + li * li
    f_re = ((nr * lr + ab_im * li) / den)[..., None]
    f_im = ((ab_im * lr - nr * li) / den)[..., None]
    bb_re = f_re * b_re - f_im * b_im
    bb_im = f_re * b_im + f_im * b_re
    return ab_re, ab_im, bb_re, bb_im


def complex_affine_combine(left, right):
    a1r, a1i, b1r, b1i = left
    a2r, a2i, b2r, b2i = right
    return (a2r * a1r - a2i * a1i,
            a2r * a1i + a2i * a1r,
            a2r * b1r - a2i * b1i + b2r,
            a2r * b1i + a2i * b1r + b2i)


def ssm_states(u, ab_re, ab_im, bb_re, bb_im, reverse, h0):
    bu_re = jnp.einsum('bngj,gpj->bngp', u, bb_re)
    bu_im = jnp.einsum('bngj,gpj->bngp', u, bb_im)
    if h0 is not None:
        h0_re, h0_im = h0
        first = -1 if reverse else 0
        bu_re = bu_re.at[:, first].add(ab_re * h0_re - ab_im * h0_im)
        bu_im = bu_im.at[:, first].add(ab_re * h0_im + ab_im * h0_re)
    a_re = jnp.broadcast_to(ab_re, bu_re.shape)
    a_im = jnp.broadcast_to(ab_im, bu_im.shape)
    _, _, h_re, h_im = lax.associative_scan(
        complex_affine_combine, (a_re, a_im, bu_re, bu_im), reverse=reverse, axis=1)
    return h_re, h_im


def ssm_readout(h_re, h_im, c_re, c_im):
    return (jnp.einsum('bngp,gjp->bngj', h_re, c_re)
            - jnp.einsum('bngp,gjp->bngj', h_im, c_im))


def mixer_merge(conv_y, ssm_y, u, ssm_d, w_glu, g_conv_out, g_ssm_out, w_out):
    s = jax.nn.gelu(ssm_y + ssm_d * u)
    s = s * jax.nn.sigmoid(s @ w_glu)
    merged = jnp.concatenate([head_rms_norm(conv_y, CONV_HEADS, g_conv_out),
                              head_rms_norm(s, SSM_GROUPS, g_ssm_out)], axis=-1)
    return merged @ w_out


def sq_relu_mlp(h, w1, w2):
    return jnp.square(jax.nn.relu(h @ w1)) @ w2


def setup_inputs(seed: int = 0) -> dict:
    key = jax.random.key(seed)
    ks = jax.random.split(key, 32)
    nrm = jax.random.normal
    f32 = jnp.float32
    G, P, J = SSM_GROUPS, SSM_STATE, SSM_GROUP
    x = nrm(ks[0], (BATCH, SEQ, D_MODEL), f32)
    c = nrm(ks[1], (BATCH, D_MODEL), f32)
    ctx = nrm(ks[2], (BATCH, CTX_LEN, D_MODEL), f32)
    c_ctx = nrm(ks[3], (D_MODEL,), f32)
    w_mod = nrm(ks[4], (DEPTH, D_MODEL, N_MOD * D_MODEL), f32) * (0.5 * D_MODEL ** -0.5)
    b_mod = 0.01 * nrm(ks[5], (DEPTH, N_MOD * D_MODEL), f32)
    g_norm1 = 1.0 + 0.01 * nrm(ks[6], (DEPTH, D_MODEL), f32)
    w_in = nrm(ks[7], (DEPTH, D_MODEL, IN_W), f32) * D_MODEL ** -0.5
    conv_w = nrm(ks[8], (DEPTH, 3, CONV_W), f32) * 3 ** -0.5
    ssm_a_re = -0.5 + 0.01 * nrm(ks[9], (DEPTH, 2, G, P), f32)
    ssm_a_im = jnp.pi * jnp.arange(P, dtype=f32) + 0.01 * nrm(ks[10], (DEPTH, 2, G, P), f32)
    ssm_log_dt = jax.random.uniform(ks[11], (DEPTH, 2, G), f32,
                                    minval=math.log(DT_MIN), maxval=math.log(DT_MAX))
    ssm_b_re = nrm(ks[12], (DEPTH, 2, G, P, J), f32) * (2 * J) ** -0.5
    ssm_b_im = nrm(ks[13], (DEPTH, 2, G, P, J), f32) * (2 * J) ** -0.5
    ssm_c_re = 0.5 * nrm(ks[14], (DEPTH, 2, G, J, P), f32)
    ssm_c_im = 0.5 * nrm(ks[15], (DEPTH, 2, G, J, P), f32)
    ssm_d = nrm(ks[16], (DEPTH, SSM_W), f32)
    w_glu = nrm(ks[17], (DEPTH, SSM_W, SSM_W), f32) * SSM_W ** -0.5
    g_conv_out = 1.0 + 0.01 * nrm(ks[18], (DEPTH, CONV_W), f32)
    g_ssm_out = 1.0 + 0.01 * nrm(ks[19], (DEPTH, SSM_W), f32)
    w_out = nrm(ks[20], (DEPTH, MIX_W, D_MODEL), f32) * MIX_W ** -0.5
    g_norm2 = 1.0 + 0.01 * nrm(ks[21], (DEPTH, D_MODEL), f32)
    w_mlp1 = nrm(ks[22], (DEPTH, D_MODEL, D_FF), f32) * D_MODEL ** -0.5
    w_mlp2 = nrm(ks[23], (DEPTH, D_FF, D_MODEL), f32) * D_FF ** -0.5
    g_final = 1.0 + 0.01 * nrm(ks[24], (D_MODEL,), f32)
    return {'x': x, 'c': c, 'ctx': ctx, 'c_ctx': c_ctx, 'w_mod': w_mod, 'b_mod': b_mod,
            'g_norm1': g_norm1, 'w_in': w_in, 'conv_w': conv_w,
            'ssm_a_re': ssm_a_re, 'ssm_a_im': ssm_a_im, 'ssm_log_dt': ssm_log_dt,
            'ssm_b_re': ssm_b_re, 'ssm_b_im': ssm_b_im, 'ssm_c_re': ssm_c_re, 'ssm_c_im': ssm_c_im,
            'ssm_d': ssm_d, 'w_glu': w_glu, 'g_conv_out': g_conv_out, 'g_ssm_out': g_ssm_out,
            'w_out': w_out, 'g_norm2': g_norm2, 'w_mlp1': w_mlp1, 'w_mlp2': w_mlp2,
            'g_final': g_final}


def reference(x, c, ctx, c_ctx, w_mod, b_mod, g_norm1, w_in, conv_w,
              ssm_a_re, ssm_a_im, ssm_log_dt, ssm_b_re, ssm_b_im, ssm_c_re, ssm_c_im,
              ssm_d, w_glu, g_conv_out, g_ssm_out, w_out, g_norm2, w_mlp1, w_mlp2, g_final):
    bsz, n_lat, _ = x.shape
    rows = n_lat // GRID_W
    n_ctx = ctx.shape[1]
    split_at = [CONV_W, 2 * CONV_W, 3 * CONV_W]
    for layer in range(DEPTH):
        last = layer == DEPTH - 1
        mod = jax.nn.silu(c) @ w_mod[layer] + b_mod[layer]
        sh1, sc1, gt1, sh2, sc2, gt2 = jnp.split(mod[:, None, :], N_MOD, axis=-1)
        mod_c = jax.nn.silu(c_ctx) @ w_mod[layer] + b_mod[layer]
        csh1, csc1, cgt1, csh2, csc2, cgt2 = jnp.split(mod_c, N_MOD)

        h_lat = rms_norm(x, g_norm1[layer]) * (1.0 + sc1) + sh1
        h_ctx = rms_norm(ctx, g_norm1[layer]) * (1.0 + csc1) + csh1
        z_lat = h_lat @ w_in[layer]
        z_ctx = h_ctx @ w_in[layer]
        bl, cl, vl, ul = jnp.split(z_lat, split_at, axis=-1)
        bc, cc, vc, uc = jnp.split(z_ctx, split_at, axis=-1)

        conv_lat = bl * short_conv((cl * vl).reshape(bsz, rows, GRID_W, CONV_W),
                                   conv_w[layer]).reshape(bsz, n_lat, CONV_W)

        ul_g = ul.reshape(bsz, n_lat, SSM_GROUPS, SSM_GROUP)
        uc_g = uc.reshape(bsz, n_ctx, SSM_GROUPS, SSM_GROUP)
        y_lat_dirs = []
        y_ctx_dirs = []
        for direction in range(2):
            reverse = direction == 1
            ab_re, ab_im, bb_re, bb_im = zoh(ssm_a_re[layer, direction], ssm_a_im[layer, direction],
                                             ssm_log_dt[layer, direction],
                                             ssm_b_re[layer, direction], ssm_b_im[layer, direction])
            hc_re, hc_im = ssm_states(uc_g, ab_re, ab_im, bb_re, bb_im, reverse, None)
            end = 0 if reverse else -1
            hl_re, hl_im = ssm_states(ul_g, ab_re, ab_im, bb_re, bb_im, reverse,
                                      (hc_re[:, end], hc_im[:, end]))
            y_lat_dirs.append(ssm_readout(hl_re, hl_im, ssm_c_re[layer, direction],
                                          ssm_c_im[layer, direction]))
            if not last:
                y_ctx_dirs.append(ssm_readout(hc_re, hc_im, ssm_c_re[layer, direction],
                                              ssm_c_im[layer, direction]))
        ssm_lat = (y_lat_dirs[0] + y_lat_dirs[1]).reshape(bsz, n_lat, SSM_W)

        mix_lat = mixer_merge(conv_lat, ssm_lat, ul, ssm_d[layer], w_glu[layer],
                              g_conv_out[layer], g_ssm_out[layer], w_out[layer])
        x_mid = x + gt1 * mix_lat
        x = x_mid + gt2 * sq_relu_mlp(rms_norm(x_mid, g_norm2[layer]) * (1.0 + sc2) + sh2,
                                      w_mlp1[layer], w_mlp2[layer])

        if not last:
            conv_ctx = bc * short_conv(cc * vc, conv_w[layer])
            ssm_ctx = (y_ctx_dirs[0] + y_ctx_dirs[1]).reshape(bsz, n_ctx, SSM_W)
            ctx_mid = ctx + cgt1 * mixer_merge(conv_ctx, ssm_ctx, uc, ssm_d[layer], w_glu[layer],
                                               g_conv_out[layer], g_ssm_out[layer], w_out[layer])
            ctx = ctx_mid + cgt2 * sq_relu_mlp(
                rms_norm(ctx_mid, g_norm2[layer]) * (1.0 + csc2) + csh2,
                w_mlp1[layer], w_mlp2[layer])
    return rms_norm(x, g_final)
```

```cpp
#include <hip/hip_runtime.h>
#include <hip/hip_cooperative_groups.h>
#include <cstdio>
namespace cg = cooperative_groups;

#define LAS __attribute__((address_space(3)))
typedef unsigned short bf16_t;
typedef short bf16x8 __attribute__((ext_vector_type(8)));
typedef float f32x4 __attribute__((ext_vector_type(4)));
typedef unsigned u32x4 __attribute__((ext_vector_type(4)));
typedef unsigned u32x2 __attribute__((ext_vector_type(2)));

constexpr int D = 1024, SEQ = 16384, CTX = 256, MROWS = SEQ + CTX, ZW = 1536, FF = 4096;
constexpr int LCH = 32, NCH = SEQ / LCH, NCHP = 768, KEXT = 768, NG = 32;
constexpr float EPS = 1e-6f;
constexpr size_t MiB = 1u << 20;
constexpr size_t WS_MOD = 0;
constexpr size_t WS_WIN = 1 * MiB, WS_WGLU = 5 * MiB, WS_WOUT = 6 * MiB, WS_W1 = 8 * MiB, WS_W2 = 16 * MiB;
constexpr size_t WS_H = 24 * MiB;
constexpr size_t WS_BEXT = 24 * MiB, WS_MS = 48 * MiB, WS_AX = 56 * MiB, WS_SB = 92 * MiB, WS_SG = 116 * MiB, WS_Z = 132 * MiB;
constexpr size_t WS_XN = 181 * MiB, WS_MG = 214 * MiB, WS_END = 246 * MiB;
constexpr int LDS_BYTES = 147456;

__device__ __forceinline__ unsigned f2bf(float f) { unsigned u = __float_as_uint(f); return (u + 0x7fffu + ((u >> 16) & 1u)) >> 16; }
__device__ __forceinline__ unsigned pk2(float lo, float hi) { unsigned r; asm volatile("v_cvt_pk_bf16_f32 %0, %1, %2" : "=v"(r) : "v"(lo), "v"(hi)); return r; }
__device__ __forceinline__ u32x4 pack8(const float (&v)[8]) { u32x4 w; w.x = pk2(v[0], v[1]); w.y = pk2(v[2], v[3]); w.z = pk2(v[4], v[5]); w.w = pk2(v[6], v[7]); return w; }
__device__ __forceinline__ void unpack8(const u32x4 w, float (&f)[8]) {
    f[0] = __uint_as_float(w.x << 16); f[1] = __uint_as_float(w.x & 0xffff0000u); f[2] = __uint_as_float(w.y << 16); f[3] = __uint_as_float(w.y & 0xffff0000u);
    f[4] = __uint_as_float(w.z << 16); f[5] = __uint_as_float(w.z & 0xffff0000u); f[6] = __uint_as_float(w.w << 16); f[7] = __uint_as_float(w.w & 0xffff0000u); }
__device__ __forceinline__ float wave_sum(float v) {
#pragma unroll
    for (int o = 1; o < 64; o <<= 1) v += __shfl_xor(v, o);
    return v; }
__device__ __forceinline__ float sigmoidf_(float a) { return 1.0f / (1.0f + __expf(-a)); }
__device__ __forceinline__ float gelu_tanh(float x) { const float u = 0.7978845608028654f * (x + 0.044715f * x * x * x); return x / (1.0f + __expf(-2.0f * u)); }
__device__ __forceinline__ void sincos_rev(double t, double& s, double& c) {
    t -= rint(t); const double q = rint(t * 4.0); const double r = (t - q * 0.25) * 6.283185307179586476925; const double r2 = r * r;
    const double sp = r * (1.0 + r2 * (-1.0 / 6 + r2 * (1.0 / 120 + r2 * (-1.0 / 5040 + r2 * (1.0 / 362880 + r2 * (-1.0 / 39916800 + r2 * (1.0 / 6227020800.0)))))));
    const double cp = 1.0 + r2 * (-0.5 + r2 * (1.0 / 24 + r2 * (-1.0 / 720 + r2 * (1.0 / 40320 + r2 * (-1.0 / 3628800 + r2 * (1.0 / 479001600 + r2 * (-1.0 / 87178291200.0)))))));
    const int qi = ((int)q) & 3;
    s = (qi == 0) ? sp : (qi == 1) ? cp : (qi == 2) ? -sp : -cp;
    c = (qi == 0) ? cp : (qi == 1) ? -sp : (qi == 2) ? -cp : sp; }

namespace pg8 {
constexpr int BM = 256, BK = 64, HALF = 128, HTB = HALF * BK * 2, STAGE_BYTES = 8 * HTB, NXCD = 8, WGM = 8;
__device__ __forceinline__ int lds_byte(int r, int c) { const int st = (r >> 4) * 2 + (c >> 5), rr = r & 15, cc = c & 31, ob = rr * 64 + cc * 2; return st * 1024 + (ob ^ (((ob >> 9) & 1) << 5)); }
__device__ __forceinline__ void stage_rc(int b, int& R, int& C) { const int st = b / 1024, sb = b % 1024, swz = sb ^ (((sb >> 9) & 1) << 5); R = (st >> 1) * 16 + swz / 64; C = (st & 1) * 32 + (swz % 64) / 2; }
__device__ __forceinline__ int perm32(int rho) { const int n = rho >> 4, i = rho & 15; return 8 * (i >> 2) + 4 * n + (i & 3); }

struct Unit { int pm, pn, bz; size_t aoff, boff; };
struct Gemm { const bf16_t* A; const bf16_t* Bt; int K, lda, ldb; };

struct Order {
    int nM, nN, per, nwg, G, c; size_t aB, bB, aT, bT;
    __device__ void init(int nM_, int nN_, int nB, int lda, int ldb, size_t aB_, size_t bB_, int G_, int c_) {
        nM = nM_; nN = nN_; per = nM * nN; nwg = per * nB; G = G_; c = c_; aB = aB_; bB = bB_; aT = (size_t)BM * lda * 2; bT = (size_t)BM * ldb * 2; }
    __device__ bool next(int i, Unit& u) const {
        const long L = (long)i * G + c; if (L >= nwg) return false;
        const int bz = (int)(L / per); int wgid = (int)(L % per);
        { const int q = per / NXCD, r = per % NXCD, xcd = wgid % NXCD, off = wgid / NXCD; wgid = (xcd < r ? xcd * (q + 1) : r * (q + 1) + (xcd - r) * q) + off; }
        const int nig = WGM * nN, gid = wgid / nig, fm = gid * WGM, gsz = (nM - fm) < WGM ? (nM - fm) : WGM;
        u.pm = fm + ((wgid % nig) % gsz); u.pn = (wgid % nig) / gsz; u.bz = bz;
        u.aoff = (size_t)bz * aB + (size_t)u.pm * aT; u.boff = (size_t)bz * bB + (size_t)u.pn * bT; return true; }
};
struct OrderP1 : Order {
    __device__ bool next(int i, Unit& u) const {
        const long L = (long)i * G + c;
        if (L < nwg) return Order::next(i, u);
        if (L < nwg + 2) { u.pm = 64; u.pn = 6 + (int)(L - nwg); u.bz = 0; u.aoff = (size_t)64 * aT; u.boff = (size_t)u.pn * bT; return true; }
        return false; }
};

template <class Epi, class Sched>
__device__ __forceinline__ void gemm_phase(LAS unsigned char* lds, const Gemm g, const Sched& S, const Epi& E) {
    const int tid = threadIdx.x, wid = __builtin_amdgcn_readfirstlane(tid >> 6), lane = tid & 63, wr = wid >> 2, wc = wid & 3, fr = lane & 15, fq = lane >> 4;
    const int K = g.K, nt = K / BK;
    unsigned voffA[2], voffB[2];
#pragma unroll
    for (int i = 0; i < 2; ++i) { int R, C; stage_rc(tid * 16 + i * 8192, R, C); const int Rb = Epi::PERM ? ((R & ~31) + perm32(R & 31)) : R;
        voffA[i] = (unsigned)(R * g.lda + C) * 2u; voffB[i] = (unsigned)(Rb * g.ldb + C) * 2u; }
    const size_t kstep = (size_t)(BK * 2);
    const size_t hstepA = (size_t)HALF * g.lda * 2, hstepB = (size_t)HALF * g.ldb * 2;
    const unsigned ldsw = (unsigned)wid * 1024u;
    const int aoff = lds_byte(wr * 64 + fr, fq * 8), boff = lds_byte(wc * 32 + fr, fq * 8);
#define PG8_SA(b, h) (((b) * 2 + (h)) * HTB)
#define PG8_SB(b, h) ((4 + (b) * 2 + (h)) * HTB)
#define PG8_STAGE(bufoff, gbase, voff) do { _Pragma("unroll") for (int _i = 0; _i < 2; ++_i) \
        __builtin_amdgcn_global_load_lds((const unsigned*)((const char*)(gbase) + (voff)[_i]), (LAS unsigned*)(lds + (bufoff) + ldsw + _i * 8192), 16, 0, 0); } while (0)
#define PG8_LDA(dst, b, h) do { _Pragma("unroll") for (int m = 0; m < 4; ++m) _Pragma("unroll") for (int k = 0; k < 2; ++k) dst[m][k] = *(const LAS bf16x8*)(lds + PG8_SA(b, h) + aoff + m * 2048 + k * 1024); } while (0)
#define PG8_LDB(dst, b, h) do { _Pragma("unroll") for (int n = 0; n < 2; ++n) _Pragma("unroll") for (int k = 0; k < 2; ++k) dst[n][k] = *(const LAS bf16x8*)(lds + PG8_SB(b, h) + boff + n * 2048 + k * 1024); } while (0)
#define PG8_MMA(ai, bj, At, Bt) do { __builtin_amdgcn_s_setprio(1); _Pragma("unroll") for (int m = 0; m < 4; ++m) _Pragma("unroll") for (int n = 0; n < 2; ++n) _Pragma("unroll") for (int k = 0; k < 2; ++k) \
        acc[ai][bj][m][n] = __builtin_amdgcn_mfma_f32_16x16x32_bf16(Bt[n][k], At[m][k], acc[ai][bj][m][n], 0, 0, 0); __builtin_amdgcn_s_setprio(0); } while (0)
#define PG8_WAIT_V(n) asm volatile("s_waitcnt vmcnt(" #n ")" ::: "memory")
#define PG8_WAIT_L(n) asm volatile("s_waitcnt lgkmcnt(" #n ")" ::: "memory")
#define PG8_BAR __builtin_amdgcn_s_barrier()
#define PG8_SCHED __builtin_amdgcn_sched_barrier(0)
    Unit cur, nxt; int ui = 0;
    if (!S.next(0, cur)) return;
    f32x4 acc[2][2][4][2];
#pragma unroll
    for (int a = 0; a < 2; ++a)
#pragma unroll
        for (int b = 0; b < 2; ++b)
#pragma unroll
            for (int m = 0; m < 4; ++m)
#pragma unroll
                for (int n = 0; n < 2; ++n) acc[a][b][m][n] = (f32x4){0.f, 0.f, 0.f, 0.f};
    bf16x8 At[4][2], B0[2][2], B1[2][2];
    const char* cA = (const char*)g.A + cur.aoff; const char* cB = (const char*)g.Bt + cur.boff;
    PG8_STAGE(PG8_SB(0, 0), cB, voffB); PG8_STAGE(PG8_SA(0, 0), cA, voffA); PG8_STAGE(PG8_SB(0, 1), cB + hstepB, voffB); PG8_STAGE(PG8_SA(0, 1), cA + hstepA, voffA);
    if (wr == 1) PG8_BAR;
    PG8_WAIT_V(4); PG8_BAR;
    PG8_STAGE(PG8_SB(1, 0), cB + kstep, voffB); PG8_STAGE(PG8_SA(1, 0), cA + kstep, voffA); PG8_STAGE(PG8_SB(1, 1), cB + hstepB + kstep, voffB);
    PG8_WAIT_V(6); PG8_BAR;
    for (;;) {
        const bool has_next = S.next(ui + 1, nxt);
        const char* nA = has_next ? (const char*)g.A + nxt.aoff : cA; const char* nB = has_next ? (const char*)g.Bt + nxt.boff : cB;
        for (int t = 0; t < nt; t += 2) {
            const bool last = (t == nt - 2);
            const char* a1 = cA + (size_t)(t + 1) * kstep;
            const char* a2 = last ? nA : cA + (size_t)(t + 2) * kstep; const char* b2 = last ? nB : cB + (size_t)(t + 2) * kstep;
            const char* a3 = a2 + kstep; const char* b3 = b2 + kstep;
            PG8_LDB(B0, 0, 0); PG8_SCHED; PG8_LDA(At, 0, 0); PG8_STAGE(PG8_SA(1, 1), a1 + hstepA, voffA);
            PG8_WAIT_L(8); PG8_BAR; PG8_WAIT_L(0); PG8_MMA(0, 0, At, B0); PG8_BAR; PG8_SCHED;
            PG8_LDB(B1, 0, 1); PG8_STAGE(PG8_SB(0, 0), b2, voffB);
            PG8_BAR; PG8_WAIT_L(0); PG8_MMA(0, 1, At, B1); PG8_BAR;
            PG8_LDA(At, 0, 1); PG8_STAGE(PG8_SA(0, 0), a2, voffA);
            PG8_BAR; PG8_WAIT_L(0); PG8_MMA(1, 0, At, B0); PG8_BAR; PG8_SCHED;
            PG8_STAGE(PG8_SB(0, 1), b2 + hstepB, voffB);
            PG8_WAIT_V(6); PG8_BAR; PG8_MMA(1, 1, At, B1); PG8_BAR;
            PG8_LDB(B0, 1, 0); PG8_SCHED; PG8_LDA(At, 1, 0); PG8_STAGE(PG8_SA(0, 1), a2 + hstepA, voffA);
            PG8_WAIT_L(8); PG8_BAR; PG8_WAIT_L(0); PG8_MMA(0, 0, At, B0); PG8_BAR; PG8_SCHED;
            PG8_LDB(B1, 1, 1); PG8_STAGE(PG8_SB(1, 0), b3, voffB);
            PG8_BAR; PG8_WAIT_L(0); PG8_MMA(0, 1, At, B1); PG8_BAR;
            PG8_LDA(At, 1, 1); PG8_STAGE(PG8_SA(1, 0), a3, voffA);
            PG8_BAR; PG8_WAIT_L(0); PG8_MMA(1, 0, At, B0); PG8_BAR; PG8_SCHED;
            PG8_STAGE(PG8_SB(1, 1), b3 + hstepB, voffB);
            PG8_WAIT_V(6); PG8_BAR; PG8_MMA(1, 1, At, B1); PG8_BAR;
        }
        E(acc, cur, wr, wc, fr, fq);
        if (!has_next) break;
#pragma unroll
        for (int a = 0; a < 2; ++a)
#pragma unroll
            for (int b = 0; b < 2; ++b)
#pragma unroll
                for (int m = 0; m < 4; ++m)
#pragma unroll
                    for (int n = 0; n < 2; ++n) acc[a][b][m][n] = (f32x4){0.f, 0.f, 0.f, 0.f};
        cur = nxt; cA = nA; cB = nB; ++ui;
    }
    PG8_WAIT_V(0);
    if (wr == 0) PG8_BAR;
    PG8_BAR;
#undef PG8_SA
#undef PG8_SB
#undef PG8_STAGE
#undef PG8_LDA
#undef PG8_LDB
#undef PG8_MMA
#undef PG8_WAIT_V
#undef PG8_WAIT_L
#undef PG8_BAR
#undef PG8_SCHED
}

#define EPI_ARGS const f32x4 (&acc)[2][2][4][2], const Unit& u, int wr, int wc, int fr, int fq
struct EpiZ { static constexpr bool PERM = true; bf16_t* Z; bf16_t* AX;
    __device__ __forceinline__ void operator()(EPI_ARGS) const {
        const int row0 = u.pm * BM + wr * 64 + fr, colb = u.pn * BM + wc * 32 + 8 * fq;
#pragma unroll
        for (int ai = 0; ai < 2; ++ai)
#pragma unroll
            for (int m = 0; m < 4; ++m) { const int row = row0 + ai * HALF + m * 16;
#pragma unroll
                for (int bj = 0; bj < 2; ++bj) { const int c = colb + bj * HALF; const f32x4 v0 = acc[ai][bj][m][0], v1 = acc[ai][bj][m][1];
                    u32x4 w; w.x = pk2(v0[0], v0[1]); w.y = pk2(v0[2], v0[3]); w.z = pk2(v1[0], v1[1]); w.w = pk2(v1[2], v1[3]);
                    if (u.pn < 6) *(u32x4*)(Z + (size_t)row * ZW + c) = w;
                    else { const int cu = c - ZW, gq = cu >> 4, j0 = cu & 15; const int chunk = row < SEQ ? (row >> 5) : NCH + ((row - SEQ) >> 5), s = row & 31;
                        *(u32x4*)(AX + ((size_t)(gq * NCHP + chunk) * KEXT + s * 16 + j0)) = w; } } }
    } };
struct EpiS1 { static constexpr bool PERM = false; float* SB;
    __device__ __forceinline__ void operator()(EPI_ARGS) const {
        const int row0 = u.pm * BM + wr * 64 + fr, col0 = wc * 32 + 4 * fq;
#pragma unroll
        for (int ai = 0; ai < 2; ++ai)
#pragma unroll
            for (int m = 0; m < 4; ++m) { float* rowp = SB + ((size_t)u.bz * NCHP + row0 + ai * HALF + m * 16) * 256 + col0;
#pragma unroll
                for (int bj = 0; bj < 2; ++bj)
#pragma unroll
                    for (int n = 0; n < 2; ++n) *(f32x4*)(rowp + bj * HALF + n * 16) = acc[ai][bj][m][n]; }
    } };
struct EpiS3 { static constexpr bool PERM = true; const bf16_t* AX; const float* dvec; bf16_t* SG;
    __device__ __forceinline__ void operator()(EPI_ARGS) const {
        const int row0 = u.pm * BM + wr * 64 + fr, colb = u.pn * BM + wc * 32 + 8 * fq;
#pragma unroll
        for (int bj = 0; bj < 2; ++bj) { const int nc = colb + bj * HALF, i = nc >> 4, j0 = nc & 15, ch = u.bz * 16 + j0;
            const f32x4 d0 = *(const f32x4*)(dvec + ch), d1 = *(const f32x4*)(dvec + ch + 4);
#pragma unroll
            for (int ai = 0; ai < 2; ++ai)
#pragma unroll
                for (int m = 0; m < 4; ++m) { const int chunk = row0 + ai * HALF + m * 16;
                    const u32x4 uw = *(const u32x4*)(AX + ((size_t)(u.bz * NCHP + chunk) * KEXT + i * 16 + j0)); float uf[8]; unpack8(uw, uf);
                    const f32x4 v0 = acc[ai][bj][m][0], v1 = acc[ai][bj][m][1]; float o[8];
#pragma unroll
                    for (int e = 0; e < 4; ++e) { o[e] = gelu_tanh(v0[e] + d0[e] * uf[e]); o[4 + e] = gelu_tanh(v1[e] + d1[e] * uf[4 + e]); }
                    *(u32x4*)(SG + ((size_t)(chunk * LCH + i) * 512 + ch)) = pack8(o); } }
    } };
struct EpiGlu { static constexpr bool PERM = true; const bf16_t* SG; const float* gout; bf16_t* MG;
    __device__ __forceinline__ void operator()(EPI_ARGS) const {
        const int row0 = u.pm * BM + wr * 64 + fr, colb = u.pn * BM + wc * 32 + 8 * fq;
#pragma unroll
        for (int bj = 0; bj < 2; ++bj) { const int c = colb + bj * HALF;
            const f32x4 g0 = *(const f32x4*)(gout + c), g1 = *(const f32x4*)(gout + c + 4);
#pragma unroll
            for (int ai = 0; ai < 2; ++ai)
#pragma unroll
                for (int m = 0; m < 4; ++m) { const int row = row0 + ai * HALF + m * 16;
                    const u32x4 sw = *(const u32x4*)(SG + (size_t)row * 512 + c); float sf[8]; unpack8(sw, sf);
                    const f32x4 v0 = acc[ai][bj][m][0], v1 = acc[ai][bj][m][1]; float o[8]; float ss = 0.f;
#pragma unroll
                    for (int e = 0; e < 4; ++e) { o[e] = sf[e] * sigmoidf_(v0[e]); o[4 + e] = sf[4 + e] * sigmoidf_(v1[e]); ss += o[e] * o[e] + o[4 + e] * o[4 + e]; }
                    ss += __shfl_xor(ss, 16);
                    const float rs = 1.0f / sqrtf(ss * (1.0f / 16.0f) + EPS);
#pragma unroll
                    for (int e = 0; e < 4; ++e) { o[e] = o[e] * rs * g0[e]; o[4 + e] = o[4 + e] * rs * g1[e]; }
                    *(u32x4*)(MG + (size_t)row * D + 512 + c) = pack8(o); } }
    } };
struct EpiOut { static constexpr bool PERM = false; const float* X; const float* gate; float* OUT;
    __device__ __forceinline__ void operator()(EPI_ARGS) const {
        const int row0 = u.pm * BM + wr * 64 + fr, col0 = u.pn * BM + wc * 32 + 4 * fq;
        f32x4 gv[2][2];
#pragma unroll
        for (int bj = 0; bj < 2; ++bj)
#pragma unroll
            for (int n = 0; n < 2; ++n) gv[bj][n] = *(const f32x4*)(gate + col0 + bj * HALF + n * 16);
#pragma unroll
        for (int ai = 0; ai < 2; ++ai)
#pragma unroll
            for (int m = 0; m < 4; ++m) { const size_t off = (size_t)(row0 + ai * HALF + m * 16) * D + col0;
#pragma unroll
                for (int bj = 0; bj < 2; ++bj)
#pragma unroll
                    for (int n = 0; n < 2; ++n) { const f32x4 xv = *(const f32x4*)(X + off + bj * HALF + n * 16); *(f32x4*)(OUT + off + bj * HALF + n * 16) = xv + gv[bj][n] * acc[ai][bj][m][n]; }
                asm volatile("" ::: "memory"); }
    } };
struct EpiMlp1 { static constexpr bool PERM = true; bf16_t* H;
    __device__ __forceinline__ void operator()(EPI_ARGS) const {
        const int row0 = u.pm * BM + wr * 64 + fr, colb = u.pn * BM + wc * 32 + 8 * fq;
#pragma unroll
        for (int ai = 0; ai < 2; ++ai)
#pragma unroll
            for (int m = 0; m < 4; ++m) { bf16_t* rowp = H + (size_t)(row0 + ai * HALF + m * 16) * FF + colb;
#pragma unroll
                for (int bj = 0; bj < 2; ++bj) { f32x4 v0 = acc[ai][bj][m][0], v1 = acc[ai][bj][m][1];
#pragma unroll
                    for (int e = 0; e < 4; ++e) { const float a = fmaxf(v0[e], 0.f), b = fmaxf(v1[e], 0.f); v0[e] = a * a; v1[e] = b * b; }
                    u32x4 w; w.x = pk2(v0[0], v0[1]); w.y = pk2(v0[2], v0[3]); w.z = pk2(v1[0], v1[1]); w.w = pk2(v1[2], v1[3]);
                    *(u32x4*)(rowp + bj * HALF) = w; } }
    } };
}

struct Args {
    const float *x, *c, *ctx, *c_ctx, *w_mod, *b_mod, *g_norm1, *w_in, *conv_w, *a_re, *a_im, *log_dt, *b_re, *b_im, *c_re, *c_im, *ssm_d, *w_glu, *g_conv_out, *g_ssm_out,
        *w_out, *g_norm2, *w_mlp1, *w_mlp2, *g_final;
    float* out; unsigned char* ws;
};

__device__ __forceinline__ void transpose_item(const float* W, int K, int N, bf16_t* WT, LAS float* scr, int item, int lane) {
    const int nblk = N / 32, kb = item / nblk, nb = item % nblk, k0 = 64 * kb, n0 = 32 * nb;
#pragma unroll 8
    for (int i = 0; i < 32; ++i) { const int kk = 2 * i + (lane >> 5); scr[kk * 33 + (lane & 31)] = W[(size_t)(k0 + kk) * N + n0 + (lane & 31)]; }
    asm volatile("s_waitcnt lgkmcnt(0)" ::: "memory");
    const int cc = lane & 7;
#pragma unroll
    for (int j = 0; j < 4; ++j) { const int n = (lane >> 3) + 8 * j; const LAS float* s = scr + (8 * cc) * 33 + n;
        u32x4 o; o.x = pk2(s[0 * 33], s[1 * 33]); o.y = pk2(s[2 * 33], s[3 * 33]); o.z = pk2(s[4 * 33], s[5 * 33]); o.w = pk2(s[6 * 33], s[7 * 33]);
        *(u32x4*)(WT + (size_t)(n0 + n) * K + k0 + 8 * cc) = o; }
    asm volatile("s_waitcnt lgkmcnt(0)" ::: "memory");
}

__device__ __forceinline__ void zoh_params(const Args& A, int d, int g, int p, double& lr, double& li, double& dt) {
    const int gi = (d * NG + g) * 64 + p;
    lr = (double)fminf(A.a_re[gi], -1e-4f); li = (double)A.a_im[gi]; dt = (double)expf(A.log_dt[d * NG + g]); }

__device__ __forceinline__ void prep_ssm_item(const Args& A, LAS float* L, int it, int tid, bf16_t* BEXT, bf16_t* MS) {
    const int g = it >> 3, kq = it & 7;
    LAS float* pwr = L; LAS float* pwi = L + 4224; LAS float* bbr = L + 8448; LAS float* bbi = L + 10496; LAS float* kt = L + 12544;
    for (int idx = tid; idx < 4224; idx += 512) {
        const int d = idx / 2112, rem = idx % 2112, p = rem / 33, k = rem % 33;
        double lr, li, dt; zoh_params(A, d, g, p, lr, li, dt);
        const float mag = expf((float)((double)k * lr * dt));
        double s, c; sincos_rev((double)k * li * dt * 0.15915494309189533577, s, c);
        pwr[idx] = mag * (float)c; pwi[idx] = mag * (float)s; }
    if (tid < 128) { const int d = tid >> 6, p = tid & 63, gi = (d * NG + g) * 64 + p;
        double lr, li, dt; zoh_params(A, d, g, p, lr, li, dt);
        const double mag = (double)expf((float)(lr * dt)); double s, c; sincos_rev(li * dt * 0.15915494309189533577, s, c);
        const double abr = mag * c, abi = mag * s, nr = abr - 1.0, den = lr * lr + li * li;
        const float fr_ = (float)((nr * lr + abi * li) / den), fi_ = (float)((abi * lr - nr * li) / den);
        const float* Br = A.b_re + (size_t)gi * 16; const float* Bi = A.b_im + (size_t)gi * 16;
#pragma unroll
        for (int j = 0; j < 16; ++j) { const float br = Br[j], bi = Bi[j]; bbr[(d * 64 + p) * 16 + j] = fr_ * br - fi_ * bi; bbi[(d * 64 + p) * 16 + j] = fr_ * bi + fi_ * br; } }
    __syncthreads();
    { const int pq = tid >> 7, t = tid & 127, d = t >> 6, kk = (t >> 4) & 3, jo = t & 15, k = kq * 4 + kk;
        float a[16];
#pragma unroll
        for (int j = 0; j < 16; ++j) a[j] = 0.f;
        const float* Cr = A.c_re + ((size_t)(d * NG + g) * 16 + jo) * 64; const float* Ci = A.c_im + ((size_t)(d * NG + g) * 16 + jo) * 64;
        for (int pp = 0; pp < 16; ++pp) { const int p = pq * 16 + pp; const float cr = Cr[p], ci = Ci[p], ar = pwr[(d * 64 + p) * 33 + k], ai = pwi[(d * 64 + p) * 33 + k];
            const float car = cr * ar - ci * ai, cai = cr * ai + ci * ar;
#pragma unroll
            for (int j = 0; j < 16; ++j) a[j] += car * bbr[(d * 64 + p) * 16 + j] - cai * bbi[(d * 64 + p) * 16 + j]; }
#pragma unroll
        for (int j = 0; j < 16; ++j) kt[((pq * 2 + d) * 4 + kk) * 256 + jo * 16 + j] = a[j]; }
    __syncthreads();
    bf16_t* Bg = BEXT + (size_t)g * 512 * KEXT;
    for (int idx = tid; idx < 8192; idx += 512) {
        const int hf = idx & 1, jo = (idx >> 1) & 15, pos = (idx >> 5) & 31, kk = (idx >> 10) & 3, d = idx >> 12, k = kq * 4 + kk;
        if (pos >= 32 - k || (k == 0 && d == 1)) continue;
        const int i = d == 0 ? pos + k : pos, s = d == 0 ? pos : pos + k;
        float v[8];
#pragma unroll
        for (int e = 0; e < 8; ++e) { const int ji = hf * 8 + e; float a = 0.f;
#pragma unroll
            for (int pq = 0; pq < 4; ++pq) { a += kt[((pq * 2 + d) * 4 + kk) * 256 + jo * 16 + ji]; if (k == 0) a += kt[((pq * 2 + 1) * 4 + kk) * 256 + jo * 16 + ji]; }
            v[e] = a; }
        *(u32x4*)(Bg + (size_t)(i * 16 + jo) * KEXT + s * 16 + hf * 8) = pack8(v); }
    for (int idx = tid; idx < 2048; idx += 512) {
        const int pp = idx & 7, ri = (idx >> 3) & 1, d = (idx >> 4) & 1, jo = (idx >> 5) & 15, ii = idx >> 9;
        const int i = kq * 4 + ii, kp = d == 0 ? i + 1 : 32 - i;
        const float* Cr = A.c_re + ((size_t)(d * NG + g) * 16 + jo) * 64 + pp * 8; const float* Ci = A.c_im + ((size_t)(d * NG + g) * 16 + jo) * 64 + pp * 8;
        float v[8];
#pragma unroll
        for (int e = 0; e < 8; ++e) { const int p = pp * 8 + e; const float cr = Cr[e], ci = Ci[e], ar = pwr[(d * 64 + p) * 33 + kp], ai = pwi[(d * 64 + p) * 33 + kp];
            v[e] = ri == 0 ? (cr * ar - ci * ai) : -(cr * ai + ci * ar); }
        *(u32x4*)(Bg + (size_t)(i * 16 + jo) * KEXT + 512 + d * 128 + ri * 64 + pp * 8) = pack8(v); }
    bf16_t* Mg = MS + (size_t)g * 256 * 512;
    for (int idx = tid; idx < 2048; idx += 512) {
        const int hf = idx & 1, ss = (idx >> 1) & 3, p = (idx >> 3) & 63, ri = (idx >> 9) & 1, d = idx >> 10;
        const int s = kq * 4 + ss, kp = d == 0 ? 31 - s : s;
        const float ar = pwr[(d * 64 + p) * 33 + kp], ai = pwi[(d * 64 + p) * 33 + kp];
        float v[8];
#pragma unroll
        for (int e = 0; e < 8; ++e) { const int ji = hf * 8 + e; const float br = bbr[(d * 64 + p) * 16 + ji], bi = bbi[(d * 64 + p) * 16 + ji];
            v[e] = ri == 0 ? (ar * br - ai * bi) : (ar * bi + ai * br); }
        *(u32x4*)(Mg + (size_t)(d * 128 + ri * 64 + p) * 512 + s * 16 + hf * 8) = pack8(v); }
    __syncthreads();
}

__device__ __forceinline__ void row_norm_mod(const float* src, bf16_t* dst, const float* gv, const float* sc, const float* sh, int lane) {
    f32x4 v[4]; float s = 0.f;
#pragma unroll
    for (int j = 0; j < 4; ++j) { v[j] = ((const f32x4*)src)[lane + 64 * j]; s += (v[j][0] * v[j][0] + v[j][1] * v[j][1]) + (v[j][2] * v[j][2] + v[j][3] * v[j][3]); }
    const float rstd = 1.0f / sqrtf(wave_sum(s) * (1.0f / D) + EPS);
#pragma unroll
    for (int j = 0; j < 4; ++j) { const int k4 = lane + 64 * j; const f32x4 g = ((const f32x4*)gv)[k4], c = ((const f32x4*)sc)[k4], h = ((const f32x4*)sh)[k4];
        const f32x4 o = v[j] * rstd * g * (1.0f + c) + h; u32x2 w; w.x = pk2(o[0], o[1]); w.y = pk2(o[2], o[3]); ((u32x2*)dst)[k4] = w; }
}

__global__ void __launch_bounds__(512, 2) hybrid_fwd(Args A) {
    extern __shared__ __attribute__((aligned(16))) unsigned char lds_raw[];
    LAS unsigned char* lds = (LAS unsigned char*)lds_raw;
    cg::grid_group grid = cg::this_grid();
    const int tid = threadIdx.x, lane = tid & 63, wave = __builtin_amdgcn_readfirstlane(tid >> 6);
    const int G = gridDim.x, bid = blockIdx.x, gw = bid * 8 + wave, NGW = G * 8;
    unsigned char* ws = A.ws;
    float* MOD = (float*)(ws + WS_MOD); float* MODC = MOD + 6144;
    bf16_t* WIN = (bf16_t*)(ws + WS_WIN); bf16_t* WGLU = (bf16_t*)(ws + WS_WGLU); bf16_t* WOUT = (bf16_t*)(ws + WS_WOUT); bf16_t* W1 = (bf16_t*)(ws + WS_W1); bf16_t* W2 = (bf16_t*)(ws + WS_W2);
    bf16_t* HB = (bf16_t*)(ws + WS_H); bf16_t* BEXT = (bf16_t*)(ws + WS_BEXT); bf16_t* MS = (bf16_t*)(ws + WS_MS); bf16_t* AX = (bf16_t*)(ws + WS_AX);
    float* SB = (float*)(ws + WS_SB); bf16_t* SG = (bf16_t*)(ws + WS_SG); bf16_t* Z = (bf16_t*)(ws + WS_Z); bf16_t* XN = (bf16_t*)(ws + WS_XN); bf16_t* MG = (bf16_t*)(ws + WS_MG);

    {
        LAS float* L = (LAS float*)lds;
        for (int it = bid; it < 192; it += G) {
            for (int k = tid; k < 1024; k += 512) { const float v = A.c[k]; L[k] = v / (1.0f + expf(-v)); const float w = A.c_ctx[k]; L[1024 + k] = w / (1.0f + expf(-w)); }
            __syncthreads();
            const int n = it * 32 + (lane & 31), half = lane >> 5; float a = 0.f, b = 0.f;
#pragma unroll 16
            for (int kk = 0; kk < 64; ++kk) { const int k = wave * 128 + 2 * kk + half; const float wv = A.w_mod[(size_t)k * 6144 + n]; a += L[k] * wv; b += L[1024 + k] * wv; }
            a += __shfl_xor(a, 32); b += __shfl_xor(b, 32);
            if (lane < 32) { L[2048 + wave * 64 + lane] = a; L[2048 + wave * 64 + 32 + lane] = b; }
            __syncthreads();
            if (tid < 64) { float s = 0.f;
#pragma unroll
                for (int w = 0; w < 8; ++w) s += L[2048 + w * 64 + tid];
                const int nn = it * 32 + (tid & 31); s += A.b_mod[nn]; if (tid < 32) MOD[nn] = s; else MODC[nn] = s; }
            __syncthreads();
        }
        for (int it = bid; it < 256; it += G) prep_ssm_item(A, L, it, tid, BEXT, MS);
        LAS float* scr = (LAS float*)(lds + wave * 16384);
        constexpr int I_IN = 16 * 64, I_GLU = 8 * 16, I_OUT = 16 * 32, I_1 = 16 * 128, I_2 = 64 * 32, NIT = I_IN + I_GLU + I_OUT + I_1 + I_2;
        for (int it = gw; it < NIT; it += NGW) { int r = it;
            if (r < I_IN) { transpose_item(A.w_in, 1024, 2048, WIN, scr, r, lane); continue; } r -= I_IN;
            if (r < I_GLU) { transpose_item(A.w_glu, 512, 512, WGLU, scr, r, lane); continue; } r -= I_GLU;
            if (r < I_OUT) { transpose_item(A.w_out, 1024, 1024, WOUT, scr, r, lane); continue; } r -= I_OUT;
            if (r < I_1) { transpose_item(A.w_mlp1, 1024, 4096, W1, scr, r, lane); continue; } r -= I_1;
            transpose_item(A.w_mlp2, 4096, 1024, W2, scr, r, lane); }
    }
    grid.sync();
    for (int r = gw; r < MROWS; r += NGW) {
        if (r < SEQ) row_norm_mod(A.x + (size_t)r * D, XN + (size_t)r * D, A.g_norm1, MOD + 1024, MOD, lane);
        else row_norm_mod(A.ctx + (size_t)(r - SEQ) * D, XN + (size_t)r * D, A.g_norm1, MODC + 1024, MODC, lane);
    }
    grid.sync();
    { pg8::Gemm g{XN, WIN, 1024, 1024, 1024}; pg8::OrderP1 S; S.init(64, 8, 1, 1024, 1024, 0, 0, G, bid);
      pg8::EpiZ E{Z, AX}; pg8::gemm_phase(lds, g, S, E); }
    grid.sync();
    { pg8::Gemm g{AX, MS, 512, KEXT, 512}; pg8::Order S; S.init(3, 1, NG, KEXT, 512, (size_t)NCHP * KEXT * 2, (size_t)256 * 512 * 2, G, bid);
      pg8::EpiS1 E{SB}; pg8::gemm_phase(lds, g, S, E); }
    grid.sync();
    {
        const int nscan = (G > 16) ? 8 : 0;
        if (G <= 16 || bid < 8) {
            for (int it = (G > 16 ? bid : bid); it < 8; it += (G > 16 ? 8 : G)) {
                const int g = it * 4 + (wave >> 1), d = wave & 1, p = lane;
                double lr, li, dt; zoh_params(A, d, g, p, lr, li, dt);
                const float mag = expf((float)(32.0 * lr * dt)); double sn, cs; sincos_rev(32.0 * li * dt * 0.15915494309189533577, sn, cs);
                const float aLr = mag * (float)cs, aLi = mag * (float)sn;
                const float* Sg = SB + (size_t)g * NCHP * 256 + d * 128 + p;
                bf16_t* Hg = AX + (size_t)g * NCHP * KEXT + 512 + d * 128 + p;
                float hr = 0.f, hi = 0.f;
#pragma unroll
                for (int q = 0; q < 8; ++q) { const int cc = d == 0 ? NCH + q : NCH + 7 - q; const float sr = Sg[(size_t)cc * 256], si = Sg[(size_t)cc * 256 + 64];
                    const float nr = aLr * hr - aLi * hi + sr, ni = aLr * hi + aLi * hr + si; hr = nr; hi = ni; }
                for (int c0 = 0; c0 < NCH; c0 += 8) {
                    float sr[8], si[8];
#pragma unroll
                    for (int e = 0; e < 8; ++e) { const int c = d == 0 ? c0 + e : NCH - 1 - (c0 + e); sr[e] = Sg[(size_t)c * 256]; si[e] = Sg[(size_t)c * 256 + 64]; }
#pragma unroll
                    for (int e = 0; e < 8; ++e) { const int c = d == 0 ? c0 + e : NCH - 1 - (c0 + e);
                        Hg[(size_t)c * KEXT] = (bf16_t)f2bf(hr); Hg[(size_t)c * KEXT + 64] = (bf16_t)f2bf(hi);
                        const float nr = aLr * hr - aLi * hi + sr[e], ni = aLr * hi + aLi * hr + si[e]; hr = nr; hi = ni; }
                }
            }
        }
        if (G <= 16 || bid >= 8) {
            const int cw = (bid - nscan) * 8 + wave, NCW = (G - nscan) * 8;
            const int ch = lane * 8;
            float w0[8], w1[8], w2[8], gc[8];
#pragma unroll
            for (int e = 0; e < 8; ++e) { w0[e] = A.conv_w[ch + e]; w1[e] = A.conv_w[512 + ch + e]; w2[e] = A.conv_w[1024 + ch + e]; gc[e] = A.g_conv_out[ch + e]; }
            for (int t = cw; t < SEQ; t += NCW) {
                const bf16_t* zr = Z + (size_t)t * ZW + ch; const int col = t & 63;
                float b[8], c1[8], v1[8], cm[8], vm[8], cp[8], vp[8];
                unpack8(*(const u32x4*)zr, b); unpack8(*(const u32x4*)(zr + 512), c1); unpack8(*(const u32x4*)(zr + 1024), v1);
                const u32x4 zero = (u32x4){0u, 0u, 0u, 0u};
                unpack8(col > 0 ? *(const u32x4*)(zr - ZW + 512) : zero, cm); unpack8(col > 0 ? *(const u32x4*)(zr - ZW + 1024) : zero, vm);
                unpack8(col < 63 ? *(const u32x4*)(zr + ZW + 512) : zero, cp); unpack8(col < 63 ? *(const u32x4*)(zr + ZW + 1024) : zero, vp);
                float o[8]; float ss = 0.f;
#pragma unroll
                for (int e = 0; e < 8; ++e) { o[e] = b[e] * (w0[e] * cm[e] * vm[e] + w1[e] * c1[e] * v1[e] + w2[e] * cp[e] * vp[e]); ss += o[e] * o[e]; }
                ss += __shfl_xor(ss, 1); ss += __shfl_xor(ss, 2); ss += __shfl_xor(ss, 4);
                const float rs = 1.0f / sqrtf(ss * (1.0f / 64.0f) + EPS);
#pragma unroll
                for (int e = 0; e < 8; ++e) o[e] = o[e] * rs * gc[e];
                *(u32x4*)(MG + (size_t)t * D + ch) = pack8(o);
            }
        }
    }
    grid.sync();
    { pg8::Gemm g{AX, BEXT, KEXT, KEXT, KEXT}; pg8::Order S; S.init(2, 2, NG, KEXT, KEXT, (size_t)NCHP * KEXT * 2, (size_t)512 * KEXT * 2, G, bid);
      pg8::EpiS3 E{AX, A.ssm_d, SG}; pg8::gemm_phase(lds, g, S, E); }
    grid.sync();
    { pg8::Gemm g{SG, WGLU, 512, 512, 512}; pg8::Order S; S.init(64, 2, 1, 512, 512, 0, 0, G, bid);
      pg8::EpiGlu E{SG, A.g_ssm_out, MG}; pg8::gemm_phase(lds, g, S, E); }
    grid.sync();
    { pg8::Gemm g{MG, WOUT, 1024, 1024, 1024}; pg8::Order S; S.init(64, 4, 1, 1024, 1024, 0, 0, G, bid);
      pg8::EpiOut E{A.x, MOD + 2048, A.out}; pg8::gemm_phase(lds, g, S, E); }
    grid.sync();
    for (int r = gw; r < SEQ; r += NGW) row_norm_mod(A.out + (size_t)r * D, XN + (size_t)r * D, A.g_norm2, MOD + 4096, MOD + 3072, lane);
    grid.sync();
    { pg8::Gemm g{XN, W1, 1024, 1024, 1024}; pg8::Order S; S.init(64, 16, 1, 1024, 1024, 0, 0, G, bid);
      pg8::EpiMlp1 E{HB}; pg8::gemm_phase(lds, g, S, E); }
    grid.sync();
    { pg8::Gemm g{HB, W2, 4096, 4096, 4096}; pg8::Order S; S.init(64, 4, 1, 4096, 4096, 0, 0, G, bid);
      pg8::EpiOut E{A.out, MOD + 5120, A.out}; pg8::gemm_phase(lds, g, S, E); }
    grid.sync();
    for (int r = gw; r < SEQ; r += NGW) {
        float* row = A.out + (size_t)r * D; f32x4 v[4]; float s = 0.f;
#pragma unroll
        for (int j = 0; j < 4; ++j) { v[j] = ((const f32x4*)row)[lane + 64 * j]; s += (v[j][0] * v[j][0] + v[j][1] * v[j][1]) + (v[j][2] * v[j][2] + v[j][3] * v[j][3]); }
        const float rstd = 1.0f / sqrtf(wave_sum(s) * (1.0f / D) + EPS);
#pragma unroll
        for (int j = 0; j < 4; ++j) { const f32x4 g = ((const f32x4*)A.g_final)[lane + 64 * j]; ((f32x4*)row)[lane + 64 * j] = v[j] * rstd * g; }
    }
}

extern "C" void kernel_launch(void* const* d_in, const int* in_sizes, int n_in, void* d_out, int out_size, void* d_ws, size_t ws_size, hipStream_t stream) {
    static int grid_blocks = 0;
    if (grid_blocks == 0) {
        if (n_in != 25 || ws_size < WS_END) { fprintf(stderr, "kernel_launch: unexpected n_in %d / ws %zu\n", n_in, ws_size); grid_blocks = -1; return; }
        int dev = 0, cus = 0, per_cu = 0;
        hipGetDevice(&dev); hipDeviceGetAttribute(&cus, hipDeviceAttributeMultiprocessorCount, dev);
        hipFuncSetAttribute((const void*)hybrid_fwd, hipFuncAttributeMaxDynamicSharedMemorySize, LDS_BYTES);
        hipOccupancyMaxActiveBlocksPerMultiprocessor(&per_cu, (const void*)hybrid_fwd, 512, LDS_BYTES);
        if (per_cu < 1) { fprintf(stderr, "kernel_launch: occupancy query says %d blocks per CU\n", per_cu); per_cu = 1; }
        grid_blocks = cus * per_cu;
    }
    if (grid_blocks < 0) return;
    Args a{};
    const float** p = (const float**)&a;
    for (int i = 0; i < 25; ++i) p[i] = (const float*)d_in[i];
    a.out = (float*)d_out; a.ws = (unsigned char*)d_ws;
    void* args[] = {&a};
    hipError_t e = hipLaunchCooperativeKernel((const void*)hybrid_fwd, dim3(grid_blocks), dim3(512), args, LDS_BYTES, stream);
    if (e != hipSuccess) fprintf(stderr, "cooperative launch failed: %s (grid %d)\n", hipGetErrorString(e), grid_blocks);
}
```

```cpp
#include <hip/hip_runtime.h>
#include <hip/hip_cooperative_groups.h>
#include <cstdio>
namespace cg = cooperative_groups;

#define LAS __attribute__((address_space(3)))
typedef unsigned short bf16_t;
typedef short bf16x8 __attribute__((ext_vector_type(8)));
typedef float f32x4 __attribute__((ext_vector_type(4)));
typedef unsigned u32x4 __attribute__((ext_vector_type(4)));
typedef unsigned u32x2 __attribute__((ext_vector_type(2)));

constexpr int D = 1024, SEQ = 16384, CTX = 256, MROWS = SEQ + CTX, ZW = 1536, FF = 4096;
constexpr int LCH = 32, NCH = SEQ / LCH, NCHP = 768, KEXT = 768, NG = 32;
constexpr float EPS = 1e-6f;
constexpr size_t MiB = 1u << 20;
constexpr size_t WS_MOD = 0;
constexpr size_t WS_CTL = 65536, CTL_BYTES = 16384;
constexpr size_t WS_WIN = 1 * MiB, WS_WGLU = 5 * MiB, WS_WOUT = 6 * MiB, WS_W1 = 8 * MiB, WS_W2 = 16 * MiB;
constexpr size_t WS_H = 24 * MiB;
constexpr size_t WS_BEXT = 24 * MiB, WS_MS = 48 * MiB, WS_AX = 56 * MiB, WS_SB = 92 * MiB, WS_SG = 116 * MiB, WS_Z = 132 * MiB;
constexpr size_t WS_XN = 181 * MiB, WS_MG = 214 * MiB, WS_END = 246 * MiB;
constexpr int LDS_BYTES = 147456;

__device__ __forceinline__ unsigned f2bf(float f) { unsigned u = __float_as_uint(f); return (u + 0x7fffu + ((u >> 16) & 1u)) >> 16; }
__device__ __forceinline__ unsigned pk2(float lo, float hi) { unsigned r; asm volatile("v_cvt_pk_bf16_f32 %0, %1, %2" : "=v"(r) : "v"(lo), "v"(hi)); return r; }
__device__ __forceinline__ u32x4 pack8(const float (&v)[8]) { u32x4 w; w.x = pk2(v[0], v[1]); w.y = pk2(v[2], v[3]); w.z = pk2(v[4], v[5]); w.w = pk2(v[6], v[7]); return w; }
__device__ __forceinline__ void unpack8(const u32x4 w, float (&f)[8]) {
    f[0] = __uint_as_float(w.x << 16); f[1] = __uint_as_float(w.x & 0xffff0000u); f[2] = __uint_as_float(w.y << 16); f[3] = __uint_as_float(w.y & 0xffff0000u);
    f[4] = __uint_as_float(w.z << 16); f[5] = __uint_as_float(w.z & 0xffff0000u); f[6] = __uint_as_float(w.w << 16); f[7] = __uint_as_float(w.w & 0xffff0000u); }
__device__ __forceinline__ float wave_sum(float v) {
#pragma unroll
    for (int o = 1; o < 64; o <<= 1) v += __shfl_xor(v, o);
    return v; }
__device__ __forceinline__ float sigmoidf_(float a) { return 1.0f / (1.0f + __expf(-a)); }
__device__ __forceinline__ float gelu_tanh(float x) { const float u = 0.7978845608028654f * (x + 0.044715f * x * x * x); return x / (1.0f + __expf(-2.0f * u)); }
__device__ __forceinline__ void sincos_rev(double t, double& s, double& c) {
    t -= rint(t); const double q = rint(t * 4.0); const double r = (t - q * 0.25) * 6.283185307179586476925; const double r2 = r * r;
    const double sp = r * (1.0 + r2 * (-1.0 / 6 + r2 * (1.0 / 120 + r2 * (-1.0 / 5040 + r2 * (1.0 / 362880 + r2 * (-1.0 / 39916800 + r2 * (1.0 / 6227020800.0)))))));
    const double cp = 1.0 + r2 * (-0.5 + r2 * (1.0 / 24 + r2 * (-1.0 / 720 + r2 * (1.0 / 40320 + r2 * (-1.0 / 3628800 + r2 * (1.0 / 479001600 + r2 * (-1.0 / 87178291200.0)))))));
    const int qi = ((int)q) & 3;
    s = (qi == 0) ? sp : (qi == 1) ? cp : (qi == 2) ? -sp : -cp;
    c = (qi == 0) ? cp : (qi == 1) ? -sp : (qi == 2) ? -cp : sp; }

namespace pg8 {
constexpr int BM = 256, BK = 64, HALF = 128, HTB = HALF * BK * 2, STAGE_BYTES = 8 * HTB, NXCD = 8, WGM = 8;
__device__ __forceinline__ int lds_byte(int r, int c) { const int st = (r >> 4) * 2 + (c >> 5), rr = r & 15, cc = c & 31, ob = rr * 64 + cc * 2; return st * 1024 + (ob ^ (((ob >> 9) & 1) << 5)); }
__device__ __forceinline__ void stage_rc(int b, int& R, int& C) { const int st = b / 1024, sb = b % 1024, swz = sb ^ (((sb >> 9) & 1) << 5); R = (st >> 1) * 16 + swz / 64; C = (st & 1) * 32 + (swz % 64) / 2; }
__device__ __forceinline__ int perm32(int rho) { const int n = rho >> 4, i = rho & 15; return 8 * (i >> 2) + 4 * n + (i & 3); }

struct Unit { int pm, pn, bz; size_t aoff, boff; };
struct Gemm { const bf16_t* A; const bf16_t* Bt; int K, lda, ldb; };

struct Order {
    int nM, nN, per, nwg, G, c; size_t aB, bB, aT, bT;
    __device__ void init(int nM_, int nN_, int nB, int lda, int ldb, size_t aB_, size_t bB_, int G_, int c_) {
        nM = nM_; nN = nN_; per = nM * nN; nwg = per * nB; G = G_; c = c_; aB = aB_; bB = bB_; aT = (size_t)BM * lda * 2; bT = (size_t)BM * ldb * 2; }
    __device__ bool next(int i, Unit& u) const {
        const long L = (long)i * G + c; if (L >= nwg) return false;
        const int bz = (int)(L / per); int wgid = (int)(L % per);
        { const int q = per / NXCD, r = per % NXCD, xcd = wgid % NXCD, off = wgid / NXCD; wgid = (xcd < r ? xcd * (q + 1) : r * (q + 1) + (xcd - r) * q) + off; }
        const int nig = WGM * nN, gid = wgid / nig, fm = gid * WGM, gsz = (nM - fm) < WGM ? (nM - fm) : WGM;
        u.pm = fm + ((wgid % nig) % gsz); u.pn = (wgid % nig) / gsz; u.bz = bz;
        u.aoff = (size_t)bz * aB + (size_t)u.pm * aT; u.boff = (size_t)bz * bB + (size_t)u.pn * bT; return true; }
};
struct OrderOne { Unit one;
    __device__ bool next(int i, Unit& u) const { if (i != 0) return false; u = one; return true; } };

template <class Epi, class Sched>
__device__ __forceinline__ void gemm_phase(LAS unsigned char* lds, const Gemm g, const Sched& S, const Epi& E) {
    const int tid = threadIdx.x, wid = __builtin_amdgcn_readfirstlane(tid >> 6), lane = tid & 63, wr = wid >> 2, wc = wid & 3, fr = lane & 15, fq = lane >> 4;
    const int K = g.K, nt = K / BK;
    unsigned voffA[2], voffB[2];
#pragma unroll
    for (int i = 0; i < 2; ++i) { int R, C; stage_rc(tid * 16 + i * 8192, R, C); const int Rb = Epi::PERM ? ((R & ~31) + perm32(R & 31)) : R;
        voffA[i] = (unsigned)(R * g.lda + C) * 2u; voffB[i] = (unsigned)(Rb * g.ldb + C) * 2u; }
    const size_t kstep = (size_t)(BK * 2);
    const size_t hstepA = (size_t)HALF * g.lda * 2, hstepB = (size_t)HALF * g.ldb * 2;
    const unsigned ldsw = (unsigned)wid * 1024u;
    const int aoff = lds_byte(wr * 64 + fr, fq * 8), boff = lds_byte(wc * 32 + fr, fq * 8);
#define PG8_SA(b, h) (((b) * 2 + (h)) * HTB)
#define PG8_SB(b, h) ((4 + (b) * 2 + (h)) * HTB)
#define PG8_STAGE(bufoff, gbase, voff) do { _Pragma("unroll") for (int _i = 0; _i < 2; ++_i) \
        __builtin_amdgcn_global_load_lds((const unsigned*)((const char*)(gbase) + (voff)[_i]), (LAS unsigned*)(lds + (bufoff) + ldsw + _i * 8192), 16, 0, 0); } while (0)
#define PG8_LDA(dst, b, h) do { _Pragma("unroll") for (int m = 0; m < 4; ++m) _Pragma("unroll") for (int k = 0; k < 2; ++k) dst[m][k] = *(const LAS bf16x8*)(lds + PG8_SA(b, h) + aoff + m * 2048 + k * 1024); } while (0)
#define PG8_LDB(dst, b, h) do { _Pragma("unroll") for (int n = 0; n < 2; ++n) _Pragma("unroll") for (int k = 0; k < 2; ++k) dst[n][k] = *(const LAS bf16x8*)(lds + PG8_SB(b, h) + boff + n * 2048 + k * 1024); } while (0)
#define PG8_MMA(ai, bj, At, Bt) do { __builtin_amdgcn_s_setprio(1); _Pragma("unroll") for (int m = 0; m < 4; ++m) _Pragma("unroll") for (int n = 0; n < 2; ++n) _Pragma("unroll") for (int k = 0; k < 2; ++k) \
        acc[ai][bj][m][n] = __builtin_amdgcn_mfma_f32_16x16x32_bf16(Bt[n][k], At[m][k], acc[ai][bj][m][n], 0, 0, 0); __builtin_amdgcn_s_setprio(0); } while (0)
#define PG8_WAIT_V(n) asm volatile("s_waitcnt vmcnt(" #n ")" ::: "memory")
#define PG8_WAIT_L(n) asm volatile("s_waitcnt lgkmcnt(" #n ")" ::: "memory")
#define PG8_BAR __builtin_amdgcn_s_barrier()
#define PG8_SCHED __builtin_amdgcn_sched_barrier(0)
    Unit cur, nxt; int ui = 0;
    if (!S.next(0, cur)) return;
    f32x4 acc[2][2][4][2];
#pragma unroll
    for (int a = 0; a < 2; ++a)
#pragma unroll
        for (int b = 0; b < 2; ++b)
#pragma unroll
            for (int m = 0; m < 4; ++m)
#pragma unroll
                for (int n = 0; n < 2; ++n) acc[a][b][m][n] = (f32x4){0.f, 0.f, 0.f, 0.f};
    bf16x8 At[4][2], B0[2][2], B1[2][2];
    const char* cA = (const char*)g.A + cur.aoff; const char* cB = (const char*)g.Bt + cur.boff;
    PG8_STAGE(PG8_SB(0, 0), cB, voffB); PG8_STAGE(PG8_SA(0, 0), cA, voffA); PG8_STAGE(PG8_SB(0, 1), cB + hstepB, voffB); PG8_STAGE(PG8_SA(0, 1), cA + hstepA, voffA);
    if (wr == 1) PG8_BAR;
    PG8_WAIT_V(4); PG8_BAR;
    PG8_STAGE(PG8_SB(1, 0), cB + kstep, voffB); PG8_STAGE(PG8_SA(1, 0), cA + kstep, voffA); PG8_STAGE(PG8_SB(1, 1), cB + hstepB + kstep, voffB);
    PG8_WAIT_V(6); PG8_BAR;
    for (;;) {
        const bool has_next = S.next(ui + 1, nxt);
        const char* nA = has_next ? (const char*)g.A + nxt.aoff : cA; const char* nB = has_next ? (const char*)g.Bt + nxt.boff : cB;
        for (int t = 0; t < nt; t += 2) {
            const bool last = (t == nt - 2);
            const char* a1 = cA + (size_t)(t + 1) * kstep;
            const char* a2 = last ? nA : cA + (size_t)(t + 2) * kstep; const char* b2 = last ? nB : cB + (size_t)(t + 2) * kstep;
            const char* a3 = a2 + kstep; const char* b3 = b2 + kstep;
            PG8_LDB(B0, 0, 0); PG8_SCHED; PG8_LDA(At, 0, 0); PG8_STAGE(PG8_SA(1, 1), a1 + hstepA, voffA);
            PG8_WAIT_L(8); PG8_BAR; PG8_WAIT_L(0); PG8_MMA(0, 0, At, B0); PG8_BAR; PG8_SCHED;
            PG8_LDB(B1, 0, 1); PG8_STAGE(PG8_SB(0, 0), b2, voffB);
            PG8_BAR; PG8_WAIT_L(0); PG8_MMA(0, 1, At, B1); PG8_BAR;
            PG8_LDA(At, 0, 1); PG8_STAGE(PG8_SA(0, 0), a2, voffA);
            PG8_BAR; PG8_WAIT_L(0); PG8_MMA(1, 0, At, B0); PG8_BAR; PG8_SCHED;
            PG8_STAGE(PG8_SB(0, 1), b2 + hstepB, voffB);
            PG8_WAIT_V(6); PG8_BAR; PG8_MMA(1, 1, At, B1); PG8_BAR;
            PG8_LDB(B0, 1, 0); PG8_SCHED; PG8_LDA(At, 1, 0); PG8_STAGE(PG8_SA(0, 1), a2 + hstepA, voffA);
            PG8_WAIT_L(8); PG8_BAR; PG8_WAIT_L(0); PG8_MMA(0, 0, At, B0); PG8_BAR; PG8_SCHED;
            PG8_LDB(B1, 1, 1); PG8_STAGE(PG8_SB(1, 0), b3, voffB);
            PG8_BAR; PG8_WAIT_L(0); PG8_MMA(0, 1, At, B1); PG8_BAR;
            PG8_LDA(At, 1, 1); PG8_STAGE(PG8_SA(1, 0), a3, voffA);
            PG8_BAR; PG8_WAIT_L(0); PG8_MMA(1, 0, At, B0); PG8_BAR; PG8_SCHED;
            PG8_STAGE(PG8_SB(1, 1), b3 + hstepB, voffB);
            PG8_WAIT_V(6); PG8_BAR; PG8_MMA(1, 1, At, B1); PG8_BAR;
        }
        E(acc, cur, wr, wc, fr, fq);
        if (!has_next) break;
#pragma unroll
        for (int a = 0; a < 2; ++a)
#pragma unroll
            for (int b = 0; b < 2; ++b)
#pragma unroll
                for (int m = 0; m < 4; ++m)
#pragma unroll
                    for (int n = 0; n < 2; ++n) acc[a][b][m][n] = (f32x4){0.f, 0.f, 0.f, 0.f};
        cur = nxt; cA = nA; cB = nB; ++ui;
    }
    PG8_WAIT_V(0);
    if (wr == 0) PG8_BAR;
    PG8_BAR;
#undef PG8_SA
#undef PG8_SB
#undef PG8_STAGE
#undef PG8_LDA
#undef PG8_LDB
#undef PG8_MMA
#undef PG8_WAIT_V
#undef PG8_WAIT_L
#undef PG8_BAR
#undef PG8_SCHED
}

#define EPI_ARGS const f32x4 (&acc)[2][2][4][2], const Unit& u, int wr, int wc, int fr, int fq
struct EpiZ { static constexpr bool PERM = true; bf16_t* Z; bf16_t* AX;
    __device__ __forceinline__ void operator()(EPI_ARGS) const {
        const int row0 = u.pm * BM + wr * 64 + fr, colb = u.pn * BM + wc * 32 + 8 * fq;
#pragma unroll
        for (int ai = 0; ai < 2; ++ai)
#pragma unroll
            for (int m = 0; m < 4; ++m) { const int row = row0 + ai * HALF + m * 16;
#pragma unroll
                for (int bj = 0; bj < 2; ++bj) { const int c = colb + bj * HALF; const f32x4 v0 = acc[ai][bj][m][0], v1 = acc[ai][bj][m][1];
                    u32x4 w; w.x = pk2(v0[0], v0[1]); w.y = pk2(v0[2], v0[3]); w.z = pk2(v1[0], v1[1]); w.w = pk2(v1[2], v1[3]);
                    if (u.pn < 6) *(u32x4*)(Z + (size_t)row * ZW + c) = w;
                    else { const int cu = c - ZW, gq = cu >> 4, j0 = cu & 15; const int chunk = row < SEQ ? (row >> 5) : NCH + (((row - SEQ) & 255) >> 5), s = row & 31;
                        *(u32x4*)(AX + ((size_t)(gq * NCHP + chunk) * KEXT + s * 16 + j0)) = w; } } }
    } };
struct EpiS1 { static constexpr bool PERM = false; float* SB;
    __device__ __forceinline__ void operator()(EPI_ARGS) const {
        const int row0 = u.pm * BM + wr * 64 + fr, col0 = wc * 32 + 4 * fq;
#pragma unroll
        for (int ai = 0; ai < 2; ++ai)
#pragma unroll
            for (int m = 0; m < 4; ++m) { float* rowp = SB + ((size_t)u.bz * NCHP + row0 + ai * HALF + m * 16) * 256 + col0;
#pragma unroll
                for (int bj = 0; bj < 2; ++bj)
#pragma unroll
                    for (int n = 0; n < 2; ++n) *(f32x4*)(rowp + bj * HALF + n * 16) = acc[ai][bj][m][n]; }
    } };
struct EpiS3 { static constexpr bool PERM = true; const bf16_t* AX; const float* dvec; bf16_t* SG;
    __device__ __forceinline__ void operator()(EPI_ARGS) const {
        const int row0 = u.pm * BM + wr * 64 + fr, colb = u.pn * BM + wc * 32 + 8 * fq;
#pragma unroll
        for (int bj = 0; bj < 2; ++bj) { const int nc = colb + bj * HALF, i = nc >> 4, j0 = nc & 15, ch = u.bz * 16 + j0;
            const f32x4 d0 = *(const f32x4*)(dvec + ch), d1 = *(const f32x4*)(dvec + ch + 4);
#pragma unroll
            for (int ai = 0; ai < 2; ++ai)
#pragma unroll
                for (int m = 0; m < 4; ++m) { const int chunk = row0 + ai * HALF + m * 16;
                    const u32x4 uw = *(const u32x4*)(AX + ((size_t)(u.bz * NCHP + chunk) * KEXT + i * 16 + j0)); float uf[8]; unpack8(uw, uf);
                    const f32x4 v0 = acc[ai][bj][m][0], v1 = acc[ai][bj][m][1]; float o[8];
#pragma unroll
                    for (int e = 0; e < 4; ++e) { o[e] = gelu_tanh(v0[e] + d0[e] * uf[e]); o[4 + e] = gelu_tanh(v1[e] + d1[e] * uf[4 + e]); }
                    *(u32x4*)(SG + ((size_t)(chunk * LCH + i) * 512 + ch)) = pack8(o); } }
    } };
struct EpiGlu { static constexpr bool PERM = true; const bf16_t* SG; const float* gout; bf16_t* MG;
    __device__ __forceinline__ void operator()(EPI_ARGS) const {
        const int row0 = u.pm * BM + wr * 64 + fr, colb = u.pn * BM + wc * 32 + 8 * fq;
#pragma unroll
        for (int bj = 0; bj < 2; ++bj) { const int c = colb + bj * HALF;
            const f32x4 g0 = *(const f32x4*)(gout + c), g1 = *(const f32x4*)(gout + c + 4);
#pragma unroll
            for (int ai = 0; ai < 2; ++ai)
#pragma unroll
                for (int m = 0; m < 4; ++m) { const int row = row0 + ai * HALF + m * 16;
                    const u32x4 sw = *(const u32x4*)(SG + (size_t)row * 512 + c); float sf[8]; unpack8(sw, sf);
                    const f32x4 v0 = acc[ai][bj][m][0], v1 = acc[ai][bj][m][1]; float o[8]; float ss = 0.f;
#pragma unroll
                    for (int e = 0; e < 4; ++e) { o[e] = sf[e] * sigmoidf_(v0[e]); o[4 + e] = sf[4 + e] * sigmoidf_(v1[e]); ss += o[e] * o[e] + o[4 + e] * o[4 + e]; }
                    ss += __shfl_xor(ss, 16);
                    const float rs = 1.0f / sqrtf(ss * (1.0f / 16.0f) + EPS);
#pragma unroll
                    for (int e = 0; e < 4; ++e) { o[e] = o[e] * rs * g0[e]; o[4 + e] = o[4 + e] * rs * g1[e]; }
                    *(u32x4*)(MG + (size_t)row * D + 512 + c) = pack8(o); } }
    } };
struct EpiOut { static constexpr bool PERM = false; const float* X; const float* gate; float* OUT;
    __device__ __forceinline__ void operator()(EPI_ARGS) const {
        const int row0 = u.pm * BM + wr * 64 + fr, col0 = u.pn * BM + wc * 32 + 4 * fq;
        f32x4 gv[2][2];
#pragma unroll
        for (int bj = 0; bj < 2; ++bj)
#pragma unroll
            for (int n = 0; n < 2; ++n) gv[bj][n] = *(const f32x4*)(gate + col0 + bj * HALF + n * 16);
#pragma unroll
        for (int ai = 0; ai < 2; ++ai)
#pragma unroll
            for (int m = 0; m < 4; ++m) { const size_t off = (size_t)(row0 + ai * HALF + m * 16) * D + col0;
#pragma unroll
                for (int bj = 0; bj < 2; ++bj)
#pragma unroll
                    for (int n = 0; n < 2; ++n) { const f32x4 xv = *(const f32x4*)(X + off + bj * HALF + n * 16); *(f32x4*)(OUT + off + bj * HALF + n * 16) = xv + gv[bj][n] * acc[ai][bj][m][n]; }
                asm volatile("" ::: "memory"); }
    } };
struct EpiMlp1 { static constexpr bool PERM = true; bf16_t* H;
    __device__ __forceinline__ void operator()(EPI_ARGS) const {
        const int row0 = u.pm * BM + wr * 64 + fr, colb = u.pn * BM + wc * 32 + 8 * fq;
#pragma unroll
        for (int ai = 0; ai < 2; ++ai)
#pragma unroll
            for (int m = 0; m < 4; ++m) { bf16_t* rowp = H + (size_t)(row0 + ai * HALF + m * 16) * FF + colb;
#pragma unroll
                for (int bj = 0; bj < 2; ++bj) { f32x4 v0 = acc[ai][bj][m][0], v1 = acc[ai][bj][m][1];
#pragma unroll
                    for (int e = 0; e < 4; ++e) { const float a = fmaxf(v0[e], 0.f), b = fmaxf(v1[e], 0.f); v0[e] = a * a; v1[e] = b * b; }
                    u32x4 w; w.x = pk2(v0[0], v0[1]); w.y = pk2(v0[2], v0[3]); w.z = pk2(v1[0], v1[1]); w.w = pk2(v1[2], v1[3]);
                    *(u32x4*)(rowp + bj * HALF) = w; } }
    } };
}

#define XB_TMO      128
#define XB_XCNT(j)  (256  + 64 * (j))
#define XB_XSUB(j)  (1280 + 64 * (j))
#define XB_XGEN(j)  (2304 + 64 * (j))
#define XB_TOP      3328
#define XB_TOPGEN   3392
#define XCD_BAR_WORDS 3456
#define XB_SPIN_CAP (1u << 18)
__device__ __forceinline__ unsigned xb_ld(unsigned* p)              { return __hip_atomic_load(p, __ATOMIC_RELAXED, __HIP_MEMORY_SCOPE_AGENT); }
__device__ __forceinline__ unsigned xb_add(unsigned* p, unsigned v) { return __hip_atomic_fetch_add(p, v, __ATOMIC_RELAXED, __HIP_MEMORY_SCOPE_AGENT); }
__device__ __forceinline__ unsigned xb_xcc_id() { return (unsigned)__builtin_amdgcn_s_getreg((3 << 11) | 20) & 0xFu; }
#define XB_SPIN(cond, bar) do { unsigned _sp = 0; while (cond) { __builtin_amdgcn_s_sleep(1); \
    if ((++_sp & 255u) == 0u) { if (xb_ld(&(bar)[XB_TMO])) break; if (_sp > XB_SPIN_CAP) { atomicAdd(&(bar)[XB_TMO], 1u); break; } } } } while (0)
struct XcdBarrier { unsigned* bar; unsigned x; volatile LAS unsigned* st; };
__device__ __forceinline__ XcdBarrier xcd_barrier_post(unsigned* bar, volatile LAS unsigned* st) {
    XcdBarrier b; b.bar = bar; b.x = xb_xcc_id(); b.st = st;
    if (threadIdx.x == 0) (void)xb_add(&bar[XB_XCNT(b.x)], 1u);
    return b; }
__device__ __forceinline__ void xcd_barrier_complete(unsigned* bar, unsigned x, unsigned& nloc, unsigned& nx) {
    const unsigned G = gridDim.x * gridDim.y * gridDim.z;
    unsigned sum, cnt, mine, sp = 0u;
    for (;;) {
        sum = 0u; cnt = 0u; mine = 0u;
#pragma unroll
        for (unsigned j = 0; j < 16; ++j) { const unsigned c = xb_ld(&bar[XB_XCNT(j)]); sum += c; cnt += (c > 0u) ? 1u : 0u; mine = (j == x) ? c : mine; }
        if (sum == G) break;
        __builtin_amdgcn_s_sleep(1);
        if ((++sp & 255u) == 0u) { if (xb_ld(&bar[XB_TMO])) break; if (sp > XB_SPIN_CAP) { atomicAdd(&bar[XB_TMO], 1u); break; } }
    }
    nloc = mine > 0u ? mine : 1u; nx = cnt > 0u ? cnt : 1u; }
__device__ __forceinline__ void xcd_barrier(const XcdBarrier& b) {
    asm volatile("s_waitcnt vmcnt(0)" ::: "memory");
    __syncthreads();
    if (threadIdx.x == 0) {
        unsigned* bar = b.bar;
        __builtin_amdgcn_s_waitcnt(0);
        unsigned nloc = b.st[0], nx = b.st[1];
        if (nloc == 0u) { xcd_barrier_complete(bar, b.x, nloc, nx); b.st[0] = nloc; b.st[1] = nx; }
        const unsigned old = xb_add(&bar[XB_XSUB(b.x)], 1u);
        const unsigned gen = old / nloc;
        if (old + 1u == (gen + 1u) * nloc) {
            __builtin_amdgcn_fence(__ATOMIC_RELEASE, "agent");
            asm volatile("s_waitcnt vmcnt(0)" ::: "memory");
            const unsigned og = xb_add(&bar[XB_TOP], 1u);
            const unsigned tg = og / nx;
            if (og + 1u == (tg + 1u) * nx) xb_add(&bar[XB_TOPGEN], 1u);
            else XB_SPIN(xb_ld(&bar[XB_TOPGEN]) == tg, bar);
            __builtin_amdgcn_fence(__ATOMIC_ACQUIRE, "agent");
            xb_add(&bar[XB_XGEN(b.x)], 1u);
            asm volatile("s_waitcnt vmcnt(0)" ::: "memory");
        } else {
            XB_SPIN(xb_ld(&bar[XB_XGEN(b.x)]) == gen, bar);
            __builtin_amdgcn_fence(__ATOMIC_ACQUIRE, "agent");
            asm volatile("s_waitcnt vmcnt(0)" ::: "memory");
        }
    }
    __syncthreads(); }

struct Args {
    const float *x, *c, *ctx, *c_ctx, *w_mod, *b_mod, *g_norm1, *w_in, *conv_w, *a_re, *a_im, *log_dt, *b_re, *b_im, *c_re, *c_im, *ssm_d, *w_glu, *g_conv_out, *g_ssm_out,
        *w_out, *g_norm2, *w_mlp1, *w_mlp2, *g_final;
    float* out; unsigned char* ws;
};

__device__ __forceinline__ void transpose_item(const float* W, int K, int N, bf16_t* WT, LAS float* scr, int item, int lane) {
    const int nblk = N / 32, kb = item / nblk, nb = item % nblk, k0 = 64 * kb, n0 = 32 * nb;
#pragma unroll 8
    for (int i = 0; i < 32; ++i) { const int kk = 2 * i + (lane >> 5); scr[kk * 33 + (lane & 31)] = W[(size_t)(k0 + kk) * N + n0 + (lane & 31)]; }
    asm volatile("s_waitcnt lgkmcnt(0)" ::: "memory");
    const int cc = lane & 7;
#pragma unroll
    for (int j = 0; j < 4; ++j) { const int n = (lane >> 3) + 8 * j; const LAS float* s = scr + (8 * cc) * 33 + n;
        u32x4 o; o.x = pk2(s[0 * 33], s[1 * 33]); o.y = pk2(s[2 * 33], s[3 * 33]); o.z = pk2(s[4 * 33], s[5 * 33]); o.w = pk2(s[6 * 33], s[7 * 33]);
        *(u32x4*)(WT + (size_t)(n0 + n) * K + k0 + 8 * cc) = o; }
    asm volatile("s_waitcnt lgkmcnt(0)" ::: "memory");
}

__device__ __forceinline__ void zoh_params(const Args& A, int d, int g, int p, double& lr, double& li, double& dt) {
    const int gi = (d * NG + g) * 64 + p;
    lr = (double)fminf(A.a_re[gi], -1e-4f); li = (double)A.a_im[gi]; dt = (double)expf(A.log_dt[d * NG + g]); }

__device__ __forceinline__ void prep_ssm_item(const Args& A, LAS float* L, int it, int tid, bf16_t* BEXT, bf16_t* MS) {
    const int g = it >> 3, kq = it & 7;
    LAS float* pwr = L; LAS float* pwi = L + 4224; LAS float* bbr = L + 8448; LAS float* bbi = L + 10496; LAS float* kt = L + 12544;
    for (int idx = tid; idx < 4224; idx += 512) {
        const int d = idx / 2112, rem = idx % 2112, p = rem / 33, k = rem % 33;
        double lr, li, dt; zoh_params(A, d, g, p, lr, li, dt);
        const float mag = expf((float)((double)k * lr * dt));
        double s, c; sincos_rev((double)k * li * dt * 0.15915494309189533577, s, c);
        pwr[idx] = mag * (float)c; pwi[idx] = mag * (float)s; }
    if (tid < 128) { const int d = tid >> 6, p = tid & 63, gi = (d * NG + g) * 64 + p;
        double lr, li, dt; zoh_params(A, d, g, p, lr, li, dt);
        const double mag = (double)expf((float)(lr * dt)); double s, c; sincos_rev(li * dt * 0.15915494309189533577, s, c);
        const double abr = mag * c, abi = mag * s, nr = abr - 1.0, den = lr * lr + li * li;
        const float fr_ = (float)((nr * lr + abi * li) / den), fi_ = (float)((abi * lr - nr * li) / den);
        const float* Br = A.b_re + (size_t)gi * 16; const float* Bi = A.b_im + (size_t)gi * 16;
#pragma unroll
        for (int j = 0; j < 16; ++j) { const float br = Br[j], bi = Bi[j]; bbr[(d * 64 + p) * 16 + j] = fr_ * br - fi_ * bi; bbi[(d * 64 + p) * 16 + j] = fr_ * bi + fi_ * br; } }
    __syncthreads();
    { const int pq = tid >> 7, t = tid & 127, d = t >> 6, kk = (t >> 4) & 3, jo = t & 15, k = kq * 4 + kk;
        float a[16];
#pragma unroll
        for (int j = 0; j < 16; ++j) a[j] = 0.f;
        const float* Cr = A.c_re + ((size_t)(d * NG + g) * 16 + jo) * 64; const float* Ci = A.c_im + ((size_t)(d * NG + g) * 16 + jo) * 64;
        for (int pp = 0; pp < 16; ++pp) { const int p = pq * 16 + pp; const float cr = Cr[p], ci = Ci[p], ar = pwr[(d * 64 + p) * 33 + k], ai = pwi[(d * 64 + p) * 33 + k];
            const float car = cr * ar - ci * ai, cai = cr * ai + ci * ar;
#pragma unroll
            for (int j = 0; j < 16; ++j) a[j] += car * bbr[(d * 64 + p) * 16 + j] - cai * bbi[(d * 64 + p) * 16 + j]; }
#pragma unroll
        for (int j = 0; j < 16; ++j) kt[((pq * 2 + d) * 4 + kk) * 256 + jo * 16 + j] = a[j]; }
    __syncthreads();
    bf16_t* Bg = BEXT + (size_t)g * 512 * KEXT;
    for (int idx = tid; idx < 8192; idx += 512) {
        const int hf = idx & 1, jo = (idx >> 1) & 15, pos = (idx >> 5) & 31, kk = (idx >> 10) & 3, d = idx >> 12, k = kq * 4 + kk;
        if (pos >= 32 - k || (k == 0 && d == 1)) continue;
        const int i = d == 0 ? pos + k : pos, s = d == 0 ? pos : pos + k;
        float v[8];
#pragma unroll
        for (int e = 0; e < 8; ++e) { const int ji = hf * 8 + e; float a = 0.f;
#pragma unroll
            for (int pq = 0; pq < 4; ++pq) { a += kt[((pq * 2 + d) * 4 + kk) * 256 + jo * 16 + ji]; if (k == 0) a += kt[((pq * 2 + 1) * 4 + kk) * 256 + jo * 16 + ji]; }
            v[e] = a; }
        *(u32x4*)(Bg + (size_t)(i * 16 + jo) * KEXT + s * 16 + hf * 8) = pack8(v); }
    for (int idx = tid; idx < 2048; idx += 512) {
        const int pp = idx & 7, ri = (idx >> 3) & 1, d = (idx >> 4) & 1, jo = (idx >> 5) & 15, ii = idx >> 9;
        const int i = kq * 4 + ii, kp = d == 0 ? i + 1 : 32 - i;
        const float* Cr = A.c_re + ((size_t)(d * NG + g) * 16 + jo) * 64 + pp * 8; const float* Ci = A.c_im + ((size_t)(d * NG + g) * 16 + jo) * 64 + pp * 8;
        float v[8];
#pragma unroll
        for (int e = 0; e < 8; ++e) { const int p = pp * 8 + e; const float cr = Cr[e], ci = Ci[e], ar = pwr[(d * 64 + p) * 33 + kp], ai = pwi[(d * 64 + p) * 33 + kp];
            v[e] = ri == 0 ? (cr * ar - ci * ai) : -(cr * ai + ci * ar); }
        *(u32x4*)(Bg + (size_t)(i * 16 + jo) * KEXT + 512 + d * 128 + ri * 64 + pp * 8) = pack8(v); }
    bf16_t* Mg = MS + (size_t)g * 256 * 512;
    for (int idx = tid; idx < 2048; idx += 512) {
        const int hf = idx & 1, ss = (idx >> 1) & 3, p = (idx >> 3) & 63, ri = (idx >> 9) & 1, d = idx >> 10;
        const int s = kq * 4 + ss, kp = d == 0 ? 31 - s : s;
        const float ar = pwr[(d * 64 + p) * 33 + kp], ai = pwi[(d * 64 + p) * 33 + kp];
        float v[8];
#pragma unroll
        for (int e = 0; e < 8; ++e) { const int ji = hf * 8 + e; const float br = bbr[(d * 64 + p) * 16 + ji], bi = bbi[(d * 64 + p) * 16 + ji];
            v[e] = ri == 0 ? (ar * br - ai * bi) : (ar * bi + ai * br); }
        *(u32x4*)(Mg + (size_t)(d * 128 + ri * 64 + p) * 512 + s * 16 + hf * 8) = pack8(v); }
    __syncthreads();
}

__device__ __forceinline__ void row_norm_mod(const float* src, bf16_t* dst, const float* gv, const float* sc, const float* sh, int lane) {
    f32x4 v[4]; float s = 0.f;
#pragma unroll
    for (int j = 0; j < 4; ++j) { v[j] = ((const f32x4*)src)[lane + 64 * j]; s += (v[j][0] * v[j][0] + v[j][1] * v[j][1]) + (v[j][2] * v[j][2] + v[j][3] * v[j][3]); }
    const float rstd = 1.0f / sqrtf(wave_sum(s) * (1.0f / D) + EPS);
#pragma unroll
    for (int j = 0; j < 4; ++j) { const int k4 = lane + 64 * j; const f32x4 g = ((const f32x4*)gv)[k4], c = ((const f32x4*)sc)[k4], h = ((const f32x4*)sh)[k4];
        const f32x4 o = v[j] * rstd * g * (1.0f + c) + h; u32x2 w; w.x = pk2(o[0], o[1]); w.y = pk2(o[2], o[3]); ((u32x2*)dst)[k4] = w; }
}

__global__ void __launch_bounds__(512, 2) hybrid_fwd(Args A) {
    extern __shared__ __attribute__((aligned(16))) unsigned char lds_raw[];
    LAS unsigned char* lds = (LAS unsigned char*)lds_raw;
    const int tid = threadIdx.x, lane = tid & 63, wave = __builtin_amdgcn_readfirstlane(tid >> 6);
    const int G = gridDim.x, bid = blockIdx.x, gw = bid * 8 + wave, NGW = G * 8;
    unsigned char* ws = A.ws;
    float* MOD = (float*)(ws + WS_MOD); float* MODC = MOD + 6144;
    bf16_t* WIN = (bf16_t*)(ws + WS_WIN); bf16_t* WGLU = (bf16_t*)(ws + WS_WGLU); bf16_t* WOUT = (bf16_t*)(ws + WS_WOUT); bf16_t* W1 = (bf16_t*)(ws + WS_W1); bf16_t* W2 = (bf16_t*)(ws + WS_W2);
    bf16_t* HB = (bf16_t*)(ws + WS_H); bf16_t* BEXT = (bf16_t*)(ws + WS_BEXT); bf16_t* MS = (bf16_t*)(ws + WS_MS); bf16_t* AX = (bf16_t*)(ws + WS_AX);
    float* SB = (float*)(ws + WS_SB); bf16_t* SG = (bf16_t*)(ws + WS_SG); bf16_t* Z = (bf16_t*)(ws + WS_Z); bf16_t* XN = (bf16_t*)(ws + WS_XN); bf16_t* MG = (bf16_t*)(ws + WS_MG);

    for (int u_ = tid; u_ < 64; u_ += 512) ((LAS unsigned*)(lds + 131072))[u_] = 0u;
    __syncthreads();
    const XcdBarrier bar = xcd_barrier_post((unsigned*)(ws + WS_CTL), (volatile LAS unsigned*)(lds + 131072 + 64));
#define GRID_BAR() xcd_barrier(bar)
    const int nctx = 2;

    {
        LAS float* L = (LAS float*)lds;
        for (int it = bid; it < 192; it += G) {
            for (int k = tid; k < 1024; k += 512) { const float v = A.c[k]; L[k] = v / (1.0f + expf(-v)); const float w = A.c_ctx[k]; L[1024 + k] = w / (1.0f + expf(-w)); }
            __syncthreads();
            const int n = it * 32 + (lane & 31), half = lane >> 5; float a = 0.f, b = 0.f;
#pragma unroll 16
            for (int kk = 0; kk < 64; ++kk) { const int k = wave * 128 + 2 * kk + half; const float wv = A.w_mod[(size_t)k * 6144 + n]; a += L[k] * wv; b += L[1024 + k] * wv; }
            a += __shfl_xor(a, 32); b += __shfl_xor(b, 32);
            if (lane < 32) { L[2048 + wave * 64 + lane] = a; L[2048 + wave * 64 + 32 + lane] = b; }
            __syncthreads();
            if (tid < 64) { float s = 0.f;
#pragma unroll
                for (int w = 0; w < 8; ++w) s += L[2048 + w * 64 + tid];
                const int nn = it * 32 + (tid & 31); s += A.b_mod[nn]; if (tid < 32) MOD[nn] = s; else MODC[nn] = s; }
            __syncthreads();
        }
        LAS float* scr = (LAS float*)(lds + wave * 16384);
        constexpr int I_IN = 16 * 64, I_GLU = 8 * 16, I_OUT = 16 * 32, I_1 = 16 * 128, I_2 = 64 * 32, NIT = I_IN + I_GLU + I_OUT + I_1 + I_2;
        for (int it = gw; it < NIT; it += NGW) { int r = it;
            if (r < I_IN) { transpose_item(A.w_in, 1024, 2048, WIN, scr, r, lane); continue; } r -= I_IN;
            if (r < I_GLU) { transpose_item(A.w_glu, 512, 512, WGLU, scr, r, lane); continue; } r -= I_GLU;
            if (r < I_OUT) { transpose_item(A.w_out, 1024, 1024, WOUT, scr, r, lane); continue; } r -= I_OUT;
            if (r < I_1) { transpose_item(A.w_mlp1, 1024, 4096, W1, scr, r, lane); continue; } r -= I_1;
            transpose_item(A.w_mlp2, 4096, 1024, W2, scr, r, lane); }
    }
    GRID_BAR();
    if (bid >= G - nctx) {
        const int b = bid - (G - nctx);
        bf16_t* XC = XN + (size_t)(SEQ + b * 256) * D;
        for (int r = wave; r < CTX; r += 8) row_norm_mod(A.ctx + (size_t)r * D, XC + (size_t)r * D, A.g_norm1, MODC + 1024, MODC, lane);
        asm volatile("s_waitcnt vmcnt(0)" ::: "memory"); __syncthreads();
        pg8::Gemm g{XN, WIN, 1024, 1024, 1024}; pg8::OrderOne S; S.one.pm = 64 + b; S.one.pn = 6 + b; S.one.bz = 0;
        S.one.aoff = (size_t)(64 + b) * 256 * 1024 * 2; S.one.boff = (size_t)(6 + b) * 256 * 1024 * 2;
        pg8::EpiZ E{Z, AX}; pg8::gemm_phase(lds, g, S, E);
    } else {
        const int GW = G - nctx;
        for (int r = gw; r < SEQ; r += GW * 8) row_norm_mod(A.x + (size_t)r * D, XN + (size_t)r * D, A.g_norm1, MOD + 1024, MOD, lane);
        for (int it = bid; it < 256; it += GW) prep_ssm_item(A, (LAS float*)lds, it, tid, BEXT, MS);
    }
    GRID_BAR();
    { pg8::Gemm g{XN, WIN, 1024, 1024, 1024}; pg8::Order S; S.init(64, 8, 1, 1024, 1024, 0, 0, G, bid);
      pg8::EpiZ E{Z, AX}; pg8::gemm_phase(lds, g, S, E); }
    GRID_BAR();
    { pg8::Gemm g{AX, MS, 512, KEXT, 512}; pg8::Order S; S.init(3, 1, NG, KEXT, 512, (size_t)NCHP * KEXT * 2, (size_t)256 * 512 * 2, G, bid);
      pg8::EpiS1 E{SB}; pg8::gemm_phase(lds, g, S, E); }
    GRID_BAR();
    {
        const int nscan = (G > 64) ? 64 : 0;
        if (nscan == 0 || bid < 64) {
            LAS float* T = (LAS float*)lds;
            for (int it = bid; it < 64; it += (nscan ? 64 : G)) {
                const int g = it >> 1, d = it & 1, p = lane;
                double lr, li, dt; zoh_params(A, d, g, p, lr, li, dt);
                double sn, cs;
                const float magL = expf((float)(32.0 * lr * dt)); sincos_rev(32.0 * li * dt * 0.15915494309189533577, sn, cs);
                const float aLr = magL * (float)cs, aLi = magL * (float)sn;
                const float magS = expf((float)(2048.0 * lr * dt)); sincos_rev(2048.0 * li * dt * 0.15915494309189533577, sn, cs);
                const float aSr = magS * (float)cs, aSi = magS * (float)sn;
                const float* Sg = SB + (size_t)g * NCHP * 256 + d * 128 + p;
                bf16_t* Hg = AX + (size_t)g * NCHP * KEXT + 512 + d * 128 + p;
                float sr[64], si[64];
                const int c_first = d == 0 ? wave * 64 : NCH - 1 - wave * 64; const long cst = d == 0 ? 1 : -1;
                { const float* qp = Sg + (size_t)c_first * 256;
#pragma unroll
                  for (int e = 0; e < 64; ++e) { sr[e] = qp[0]; si[e] = qp[64]; qp += cst * 256; asm volatile("" : "+v"(qp)); } }
                float hr = 0.f, hi = 0.f;
                if (wave == 0) {
#pragma unroll
                    for (int q = 0; q < 8; ++q) { const int cc = d == 0 ? NCH + q : NCH + 7 - q; const float xr = Sg[(size_t)cc * 256], xi = Sg[(size_t)cc * 256 + 64];
                        const float nr = aLr * hr - aLi * hi + xr, ni = aLr * hi + aLi * hr + xi; hr = nr; hi = ni; }
                }
                float cr = hr, ci = hi;
#pragma unroll
                for (int e = 0; e < 64; ++e) { const float nr = aLr * hr - aLi * hi + sr[e], ni = aLr * hi + aLi * hr + si[e]; hr = nr; hi = ni; }
                T[(wave * 64 + p) * 2] = hr; T[(wave * 64 + p) * 2 + 1] = hi;
                __syncthreads();
                if (wave > 0) { float er = T[p * 2], ei = T[p * 2 + 1];
                    for (int v = 1; v < wave; ++v) { const float tr = T[(v * 64 + p) * 2], ti = T[(v * 64 + p) * 2 + 1]; const float nr = aSr * er - aSi * ei + tr, ni = aSr * ei + aSi * er + ti; er = nr; ei = ni; }
                    cr = er; ci = ei; }
                hr = cr; hi = ci;
                { bf16_t* hp = Hg + (size_t)c_first * KEXT;
#pragma unroll
                  for (int e = 0; e < 64; ++e) { hp[0] = (bf16_t)f2bf(hr); hp[64] = (bf16_t)f2bf(hi); hp += cst * KEXT; asm volatile("" : "+v"(hp));
                    const float nr = aLr * hr - aLi * hi + sr[e], ni = aLr * hi + aLi * hr + si[e]; hr = nr; hi = ni; } }
                __syncthreads();
            }
        }
        if (nscan == 0 || bid >= 64) {
            const int cw = (bid - nscan) * 8 + wave, NCW = (G - nscan) * 8;
            const int ch = lane * 8;
            float w0[8], w1[8], w2[8], gc[8];
#pragma unroll
            for (int e = 0; e < 8; ++e) { w0[e] = A.conv_w[ch + e]; w1[e] = A.conv_w[512 + ch + e]; w2[e] = A.conv_w[1024 + ch + e]; gc[e] = A.g_conv_out[ch + e]; }
            for (int t = cw; t < SEQ; t += NCW) {
                const bf16_t* zr = Z + (size_t)t * ZW + ch; const int col = t & 63;
                float b[8], c1[8], v1[8], cm[8], vm[8], cp[8], vp[8];
                unpack8(*(const u32x4*)zr, b); unpack8(*(const u32x4*)(zr + 512), c1); unpack8(*(const u32x4*)(zr + 1024), v1);
                const u32x4 zero = (u32x4){0u, 0u, 0u, 0u};
                unpack8(col > 0 ? *(const u32x4*)(zr - ZW + 512) : zero, cm); unpack8(col > 0 ? *(const u32x4*)(zr - ZW + 1024) : zero, vm);
                unpack8(col < 63 ? *(const u32x4*)(zr + ZW + 512) : zero, cp); unpack8(col < 63 ? *(const u32x4*)(zr + ZW + 1024) : zero, vp);
                float o[8]; float ss = 0.f;
#pragma unroll
                for (int e = 0; e < 8; ++e) { o[e] = b[e] * (w0[e] * cm[e] * vm[e] + w1[e] * c1[e] * v1[e] + w2[e] * cp[e] * vp[e]); ss += o[e] * o[e]; }
                ss += __shfl_xor(ss, 1); ss += __shfl_xor(ss, 2); ss += __shfl_xor(ss, 4);
                const float rs = 1.0f / sqrtf(ss * (1.0f / 64.0f) + EPS);
#pragma unroll
                for (int e = 0; e < 8; ++e) o[e] = o[e] * rs * gc[e];
                *(u32x4*)(MG + (size_t)t * D + ch) = pack8(o);
            }
        }
    }
    GRID_BAR();
    { pg8::Gemm g{AX, BEXT, KEXT, KEXT, KEXT}; pg8::Order S; S.init(2, 2, NG, KEXT, KEXT, (size_t)NCHP * KEXT * 2, (size_t)512 * KEXT * 2, G, bid);
      pg8::EpiS3 E{AX, A.ssm_d, SG}; pg8::gemm_phase(lds, g, S, E); }
    GRID_BAR();
    { pg8::Gemm g{SG, WGLU, 512, 512, 512}; pg8::Order S; S.init(64, 2, 1, 512, 512, 0, 0, G, bid);
      pg8::EpiGlu E{SG, A.g_ssm_out, MG}; pg8::gemm_phase(lds, g, S, E); }
    GRID_BAR();
    { pg8::Gemm g{MG, WOUT, 1024, 1024, 1024}; pg8::Order S; S.init(64, 4, 1, 1024, 1024, 0, 0, G, bid);
      pg8::EpiOut E{A.x, MOD + 2048, A.out}; pg8::gemm_phase(lds, g, S, E); }
    GRID_BAR();
    for (int r = gw; r < SEQ; r += NGW) row_norm_mod(A.out + (size_t)r * D, XN + (size_t)r * D, A.g_norm2, MOD + 4096, MOD + 3072, lane);
    GRID_BAR();
    { pg8::Gemm g{XN, W1, 1024, 1024, 1024}; pg8::Order S; S.init(64, 16, 1, 1024, 1024, 0, 0, G, bid);
      pg8::EpiMlp1 E{HB}; pg8::gemm_phase(lds, g, S, E); }
    GRID_BAR();
    { pg8::Gemm g{HB, W2, 4096, 4096, 4096}; pg8::Order S; S.init(64, 4, 1, 4096, 4096, 0, 0, G, bid);
      pg8::EpiOut E{A.out, MOD + 5120, A.out}; pg8::gemm_phase(lds, g, S, E); }
    GRID_BAR();
    for (int r = gw; r < SEQ; r += NGW) {
        float* row = A.out + (size_t)r * D; f32x4 v[4]; float s = 0.f;
#pragma unroll
        for (int j = 0; j < 4; ++j) { v[j] = ((const f32x4*)row)[lane + 64 * j]; s += (v[j][0] * v[j][0] + v[j][1] * v[j][1]) + (v[j][2] * v[j][2] + v[j][3] * v[j][3]); }
        const float rstd = 1.0f / sqrtf(wave_sum(s) * (1.0f / D) + EPS);
#pragma unroll
        for (int j = 0; j < 4; ++j) { const f32x4 g = ((const f32x4*)A.g_final)[lane + 64 * j]; ((f32x4*)row)[lane + 64 * j] = v[j] * rstd * g; }
    }
}

extern "C" void kernel_launch(void* const* d_in, const int* in_sizes, int n_in, void* d_out, int out_size, void* d_ws, size_t ws_size, hipStream_t stream) {
    static int grid_blocks = 0;
    if (grid_blocks == 0) {
        if (n_in != 25 || ws_size < WS_END) { fprintf(stderr, "kernel_launch: unexpected n_in %d / ws %zu\n", n_in, ws_size); grid_blocks = -1; return; }
        int dev = 0, cus = 0, per_cu = 0;
        (void)hipGetDevice(&dev); (void)hipDeviceGetAttribute(&cus, hipDeviceAttributeMultiprocessorCount, dev);
        (void)hipFuncSetAttribute((const void*)hybrid_fwd, hipFuncAttributeMaxDynamicSharedMemorySize, LDS_BYTES);
        (void)hipOccupancyMaxActiveBlocksPerMultiprocessor(&per_cu, (const void*)hybrid_fwd, 512, LDS_BYTES);
        if (per_cu < 1) { fprintf(stderr, "kernel_launch: occupancy query says %d blocks per CU\n", per_cu); per_cu = 1; }
        grid_blocks = cus * per_cu;
        if (grid_blocks < 8) { fprintf(stderr, "kernel_launch: grid %d too small\n", grid_blocks); grid_blocks = -1; return; }
    }
    if (grid_blocks < 0) return;
    if (hipMemsetAsync((char*)d_ws + WS_CTL, 0, CTL_BYTES, stream) != hipSuccess) { fprintf(stderr, "kernel_launch: memset failed\n"); return; }
    Args a{};
    const float** p = (const float**)&a;
    for (int i = 0; i < 25; ++i) p[i] = (const float*)d_in[i];
    a.out = (float*)d_out; a.ws = (unsigned char*)d_ws;
    void* args[] = {&a};
    hipError_t e = hipLaunchCooperativeKernel((const void*)hybrid_fwd, dim3(grid_blocks), dim3(512), args, LDS_BYTES, stream);
    if (e != hipSuccess) fprintf(stderr, "cooperative launch failed: %s (grid %d)\n", hipGetErrorString(e), grid_blocks);
}
```

```cpp
#include <hip/hip_runtime.h>
#include <hip/hip_cooperative_groups.h>
#include <cstdio>
namespace cg = cooperative_groups;

#define LAS __attribute__((address_space(3)))
typedef unsigned short bf16_t;
typedef short bf16x8 __attribute__((ext_vector_type(8)));
typedef float f32x4 __attribute__((ext_vector_type(4)));
typedef unsigned u32x4 __attribute__((ext_vector_type(4)));
typedef unsigned u32x2 __attribute__((ext_vector_type(2)));

constexpr int D = 1024, SEQ = 16384, CTX = 256, MROWS = SEQ + CTX, ZW = 1536, FF = 4096;
constexpr int LCH = 32, NCH = SEQ / LCH, NCHP = 768, KEXT = 768, NG = 32;
constexpr float EPS = 1e-6f;
constexpr size_t MiB = 1u << 20;
constexpr size_t WS_MOD = 0;
constexpr size_t WS_CTL = 65536, CTL_BYTES = 16384;
constexpr size_t WS_WIN = 1 * MiB, WS_WGLU = 5 * MiB, WS_WOUT = 6 * MiB, WS_W1 = 8 * MiB, WS_W2 = 16 * MiB;
constexpr size_t WS_H = 24 * MiB;
constexpr size_t WS_BEXT = 24 * MiB, WS_MS = 48 * MiB, WS_AX = 56 * MiB, WS_SB = 92 * MiB, WS_SG = 116 * MiB, WS_Z = 132 * MiB;
constexpr size_t WS_XN = 181 * MiB, WS_MG = 214 * MiB, WS_END = 246 * MiB;
constexpr int LDS_BYTES = 147456;

__device__ __forceinline__ unsigned f2bf(float f) { unsigned u = __float_as_uint(f); return (u + 0x7fffu + ((u >> 16) & 1u)) >> 16; }
__device__ __forceinline__ unsigned pk2(float lo, float hi) { unsigned r; asm volatile("v_cvt_pk_bf16_f32 %0, %1, %2" : "=v"(r) : "v"(lo), "v"(hi)); return r; }
__device__ __forceinline__ u32x4 pack8(const float (&v)[8]) { u32x4 w; w.x = pk2(v[0], v[1]); w.y = pk2(v[2], v[3]); w.z = pk2(v[4], v[5]); w.w = pk2(v[6], v[7]); return w; }
__device__ __forceinline__ void unpack8(const u32x4 w, float (&f)[8]) {
    f[0] = __uint_as_float(w.x << 16); f[1] = __uint_as_float(w.x & 0xffff0000u); f[2] = __uint_as_float(w.y << 16); f[3] = __uint_as_float(w.y & 0xffff0000u);
    f[4] = __uint_as_float(w.z << 16); f[5] = __uint_as_float(w.z & 0xffff0000u); f[6] = __uint_as_float(w.w << 16); f[7] = __uint_as_float(w.w & 0xffff0000u); }
__device__ __forceinline__ float wave_sum(float v) {
#pragma unroll
    for (int o = 1; o < 64; o <<= 1) v += __shfl_xor(v, o);
    return v; }
__device__ __forceinline__ float sigmoidf_(float a) { return 1.0f / (1.0f + __expf(-a)); }
__device__ __forceinline__ float gelu_tanh(float x) { const float u = 0.7978845608028654f * (x + 0.044715f * x * x * x); return x / (1.0f + __expf(-2.0f * u)); }
__device__ __forceinline__ void sincos_rev(double t, double& s, double& c) {
    t -= rint(t); const double q = rint(t * 4.0); const double r = (t - q * 0.25) * 6.283185307179586476925; const double r2 = r * r;
    const double sp = r * (1.0 + r2 * (-1.0 / 6 + r2 * (1.0 / 120 + r2 * (-1.0 / 5040 + r2 * (1.0 / 362880 + r2 * (-1.0 / 39916800 + r2 * (1.0 / 6227020800.0)))))));
    const double cp = 1.0 + r2 * (-0.5 + r2 * (1.0 / 24 + r2 * (-1.0 / 720 + r2 * (1.0 / 40320 + r2 * (-1.0 / 3628800 + r2 * (1.0 / 479001600 + r2 * (-1.0 / 87178291200.0)))))));
    const int qi = ((int)q) & 3;
    s = (qi == 0) ? sp : (qi == 1) ? cp : (qi == 2) ? -sp : -cp;
    c = (qi == 0) ? cp : (qi == 1) ? -sp : (qi == 2) ? -cp : sp; }

namespace pg8 {
constexpr int BM = 256, BK = 64, HALF = 128, HTB = HALF * BK * 2, STAGE_BYTES = 8 * HTB, NXCD = 8, WGM = 8;
__device__ __forceinline__ int lds_byte(int r, int c) { const int st = (r >> 4) * 2 + (c >> 5), rr = r & 15, cc = c & 31, ob = rr * 64 + cc * 2; return st * 1024 + (ob ^ (((ob >> 9) & 1) << 5)); }
__device__ __forceinline__ void stage_rc(int b, int& R, int& C) { const int st = b / 1024, sb = b % 1024, swz = sb ^ (((sb >> 9) & 1) << 5); R = (st >> 1) * 16 + swz / 64; C = (st & 1) * 32 + (swz % 64) / 2; }
__device__ __forceinline__ int perm32(int rho) { const int n = rho >> 4, i = rho & 15; return 8 * (i >> 2) + 4 * n + (i & 3); }

struct Unit { int pm, pn, bz; size_t aoff, boff; };
struct Gemm { const bf16_t* A; const bf16_t* Bt; int K, lda, ldb; };

struct Order {
    int nM, nN, per, nwg, G, c; size_t aB, bB, aT, bT;
    __device__ void init(int nM_, int nN_, int nB, int lda, int ldb, size_t aB_, size_t bB_, int G_, int c_) {
        nM = nM_; nN = nN_; per = nM * nN; nwg = per * nB; G = G_; c = c_; aB = aB_; bB = bB_; aT = (size_t)BM * lda * 2; bT = (size_t)BM * ldb * 2; }
    __device__ bool next(int i, Unit& u) const {
        const long L = (long)i * G + c; if (L >= nwg) return false;
        const int bz = (int)(L / per); int wgid = (int)(L % per);
        { const int q = per / NXCD, r = per % NXCD, xcd = wgid % NXCD, off = wgid / NXCD; wgid = (xcd < r ? xcd * (q + 1) : r * (q + 1) + (xcd - r) * q) + off; }
        const int nig = WGM * nN, gid = wgid / nig, fm = gid * WGM, gsz = (nM - fm) < WGM ? (nM - fm) : WGM;
        u.pm = fm + ((wgid % nig) % gsz); u.pn = (wgid % nig) / gsz; u.bz = bz;
        u.aoff = (size_t)bz * aB + (size_t)u.pm * aT; u.boff = (size_t)bz * bB + (size_t)u.pn * bT; return true; }
};
struct OrderOne { Unit one;
    __device__ bool next(int i, Unit& u) const { if (i != 0) return false; u = one; return true; } };

template <class Epi, class Sched>
__device__ __forceinline__ void gemm_phase(LAS unsigned char* lds, const Gemm g, const Sched& S, const Epi& E) {
    int tid = threadIdx.x; asm volatile("" : "+v"(tid));
    const int wid = __builtin_amdgcn_readfirstlane(tid >> 6), lane = tid & 63, wr = wid >> 2, wc = wid & 3, fr = lane & 15, fq = lane >> 4;
    const int K = g.K, nt = K / BK;
    unsigned voffA[2], voffB[2];
#pragma unroll
    for (int i = 0; i < 2; ++i) { int R, C; stage_rc(tid * 16 + i * 8192, R, C); const int Rb = Epi::PERM ? ((R & ~31) + perm32(R & 31)) : R;
        voffA[i] = (unsigned)(R * g.lda + C) * 2u; voffB[i] = (unsigned)(Rb * g.ldb + C) * 2u; }
    const size_t kstep = (size_t)(BK * 2);
    const size_t hstepA = (size_t)HALF * g.lda * 2, hstepB = (size_t)HALF * g.ldb * 2;
    const unsigned ldsw = (unsigned)wid * 1024u;
    const int aoff = lds_byte(wr * 64 + fr, fq * 8), boff = lds_byte(wc * 32 + fr, fq * 8);
#define PG8_SA(b, h) (((b) * 2 + (h)) * HTB)
#define PG8_SB(b, h) ((4 + (b) * 2 + (h)) * HTB)
#define PG8_STAGE(bufoff, gbase, voff) do { _Pragma("unroll") for (int _i = 0; _i < 2; ++_i) \
        __builtin_amdgcn_global_load_lds((const unsigned*)((const char*)(gbase) + (voff)[_i]), (LAS unsigned*)(lds + (bufoff) + ldsw + _i * 8192), 16, 0, 0); } while (0)
#define PG8_LDA(dst, b, h) do { _Pragma("unroll") for (int m = 0; m < 4; ++m) _Pragma("unroll") for (int k = 0; k < 2; ++k) dst[m][k] = *(const LAS bf16x8*)(lds + PG8_SA(b, h) + aoff + m * 2048 + k * 1024); } while (0)
#define PG8_LDB(dst, b, h) do { _Pragma("unroll") for (int n = 0; n < 2; ++n) _Pragma("unroll") for (int k = 0; k < 2; ++k) dst[n][k] = *(const LAS bf16x8*)(lds + PG8_SB(b, h) + boff + n * 2048 + k * 1024); } while (0)
#define PG8_MMA(ai, bj, At, Bt) do { __builtin_amdgcn_s_setprio(1); _Pragma("unroll") for (int m = 0; m < 4; ++m) _Pragma("unroll") for (int n = 0; n < 2; ++n) _Pragma("unroll") for (int k = 0; k < 2; ++k) \
        acc[ai][bj][m][n] = __builtin_amdgcn_mfma_f32_16x16x32_bf16(Bt[n][k], At[m][k], acc[ai][bj][m][n], 0, 0, 0); __builtin_amdgcn_s_setprio(0); } while (0)
#define PG8_WAIT_V(n) asm volatile("s_waitcnt vmcnt(" #n ")" ::: "memory")
#define PG8_WAIT_L(n) asm volatile("s_waitcnt lgkmcnt(" #n ")" ::: "memory")
#define PG8_BAR __builtin_amdgcn_s_barrier()
#define PG8_SCHED __builtin_amdgcn_sched_barrier(0)
    Unit cur, nxt; int ui = 0;
    if (!S.next(0, cur)) return;
    f32x4 acc[2][2][4][2];
#pragma unroll
    for (int a = 0; a < 2; ++a)
#pragma unroll
        for (int b = 0; b < 2; ++b)
#pragma unroll
            for (int m = 0; m < 4; ++m)
#pragma unroll
                for (int n = 0; n < 2; ++n) acc[a][b][m][n] = (f32x4){0.f, 0.f, 0.f, 0.f};
    bf16x8 At[4][2], B0[2][2], B1[2][2];
    const char* cA = (const char*)g.A + cur.aoff; const char* cB = (const char*)g.Bt + cur.boff;
    PG8_STAGE(PG8_SB(0, 0), cB, voffB); PG8_STAGE(PG8_SA(0, 0), cA, voffA); PG8_STAGE(PG8_SB(0, 1), cB + hstepB, voffB); PG8_STAGE(PG8_SA(0, 1), cA + hstepA, voffA);
    if (wr == 1) PG8_BAR;
    PG8_WAIT_V(4); PG8_BAR;
    PG8_STAGE(PG8_SB(1, 0), cB + kstep, voffB); PG8_STAGE(PG8_SA(1, 0), cA + kstep, voffA); PG8_STAGE(PG8_SB(1, 1), cB + hstepB + kstep, voffB);
    PG8_WAIT_V(6); PG8_BAR;
    for (;;) {
        const bool has_next = S.next(ui + 1, nxt);
        const char* nA = has_next ? (const char*)g.A + nxt.aoff : cA; const char* nB = has_next ? (const char*)g.Bt + nxt.boff : cB;
        for (int t = 0; t < nt; t += 2) {
            const bool last = (t == nt - 2);
            const char* a1 = cA + (size_t)(t + 1) * kstep;
            const char* a2 = last ? nA : cA + (size_t)(t + 2) * kstep; const char* b2 = last ? nB : cB + (size_t)(t + 2) * kstep;
            const char* a3 = a2 + kstep; const char* b3 = b2 + kstep;
            PG8_LDB(B0, 0, 0); PG8_SCHED; PG8_LDA(At, 0, 0); PG8_STAGE(PG8_SA(1, 1), a1 + hstepA, voffA);
            PG8_WAIT_L(8); PG8_BAR; PG8_WAIT_L(0); PG8_MMA(0, 0, At, B0); PG8_BAR; PG8_SCHED;
            PG8_LDB(B1, 0, 1); PG8_STAGE(PG8_SB(0, 0), b2, voffB);
            PG8_BAR; PG8_WAIT_L(0); PG8_MMA(0, 1, At, B1); PG8_BAR;
            PG8_LDA(At, 0, 1); PG8_STAGE(PG8_SA(0, 0), a2, voffA);
            PG8_BAR; PG8_WAIT_L(0); PG8_MMA(1, 0, At, B0); PG8_BAR; PG8_SCHED;
            PG8_STAGE(PG8_SB(0, 1), b2 + hstepB, voffB);
            PG8_WAIT_V(6); PG8_BAR; PG8_MMA(1, 1, At, B1); PG8_BAR;
            PG8_LDB(B0, 1, 0); PG8_SCHED; PG8_LDA(At, 1, 0); PG8_STAGE(PG8_SA(0, 1), a2 + hstepA, voffA);
            PG8_WAIT_L(8); PG8_BAR; PG8_WAIT_L(0); PG8_MMA(0, 0, At, B0); PG8_BAR; PG8_SCHED;
            PG8_LDB(B1, 1, 1); PG8_STAGE(PG8_SB(1, 0), b3, voffB);
            PG8_BAR; PG8_WAIT_L(0); PG8_MMA(0, 1, At, B1); PG8_BAR;
            PG8_LDA(At, 1, 1); PG8_STAGE(PG8_SA(1, 0), a3, voffA);
            PG8_BAR; PG8_WAIT_L(0); PG8_MMA(1, 0, At, B0); PG8_BAR; PG8_SCHED;
            PG8_STAGE(PG8_SB(1, 1), b3 + hstepB, voffB);
            PG8_WAIT_V(6); PG8_BAR; PG8_MMA(1, 1, At, B1); PG8_BAR;
        }
        E(acc, cur, wr, wc, fr, fq);
        if (!has_next) break;
#pragma unroll
        for (int a = 0; a < 2; ++a)
#pragma unroll
            for (int b = 0; b < 2; ++b)
#pragma unroll
                for (int m = 0; m < 4; ++m)
#pragma unroll
                    for (int n = 0; n < 2; ++n) acc[a][b][m][n] = (f32x4){0.f, 0.f, 0.f, 0.f};
        cur = nxt; cA = nA; cB = nB; ++ui;
    }
    PG8_WAIT_V(0);
    if (wr == 0) PG8_BAR;
    PG8_BAR;
#undef PG8_SA
#undef PG8_SB
#undef PG8_STAGE
#undef PG8_LDA
#undef PG8_LDB
#undef PG8_MMA
#undef PG8_WAIT_V
#undef PG8_WAIT_L
#undef PG8_BAR
#undef PG8_SCHED
}

#define EPI_ARGS const f32x4 (&acc)[2][2][4][2], const Unit& u, int wr, int wc, int fr, int fq
struct EpiZ { static constexpr bool PERM = true; bf16_t* Z; bf16_t* AX;
    __device__ __forceinline__ void operator()(EPI_ARGS) const {
        const int row0 = u.pm * BM + wr * 64 + fr, colb = u.pn * BM + wc * 32 + 8 * fq;
#pragma unroll
        for (int ai = 0; ai < 2; ++ai)
#pragma unroll
            for (int m = 0; m < 4; ++m) { const int row = row0 + ai * HALF + m * 16;
#pragma unroll
                for (int bj = 0; bj < 2; ++bj) { const int c = colb + bj * HALF; const f32x4 v0 = acc[ai][bj][m][0], v1 = acc[ai][bj][m][1];
                    u32x4 w; w.x = pk2(v0[0], v0[1]); w.y = pk2(v0[2], v0[3]); w.z = pk2(v1[0], v1[1]); w.w = pk2(v1[2], v1[3]);
                    if (u.pn < 6) *(u32x4*)(Z + (size_t)row * ZW + c) = w;
                    else { const int cu = c - ZW, gq = cu >> 4, j0 = cu & 15; const int chunk = row < SEQ ? (row >> 5) : NCH + (((row - SEQ) & 255) >> 5), s = row & 31;
                        *(u32x4*)(AX + ((size_t)(gq * NCHP + chunk) * KEXT + s * 16 + j0)) = w; } } }
    } };
struct EpiS1 { static constexpr bool PERM = false; float* SB;
    __device__ __forceinline__ void operator()(EPI_ARGS) const {
        const int row0 = u.pm * BM + wr * 64 + fr, col0 = wc * 32 + 4 * fq;
#pragma unroll
        for (int ai = 0; ai < 2; ++ai)
#pragma unroll
            for (int m = 0; m < 4; ++m) { float* rowp = SB + ((size_t)u.bz * NCHP + row0 + ai * HALF + m * 16) * 256 + col0;
#pragma unroll
                for (int bj = 0; bj < 2; ++bj)
#pragma unroll
                    for (int n = 0; n < 2; ++n) *(f32x4*)(rowp + bj * HALF + n * 16) = acc[ai][bj][m][n]; }
    } };
struct EpiS3 { static constexpr bool PERM = true; const bf16_t* AX; const float* dvec; bf16_t* SG;
    __device__ __forceinline__ void operator()(EPI_ARGS) const {
        const int row0 = u.pm * BM + wr * 64 + fr, colb = u.pn * BM + wc * 32 + 8 * fq;
#pragma unroll
        for (int bj = 0; bj < 2; ++bj) { const int nc = colb + bj * HALF, i = nc >> 4, j0 = nc & 15, ch = u.bz * 16 + j0;
            const f32x4 d0 = *(const f32x4*)(dvec + ch), d1 = *(const f32x4*)(dvec + ch + 4);
#pragma unroll
            for (int ai = 0; ai < 2; ++ai)
#pragma unroll
                for (int m = 0; m < 4; ++m) { const int chunk = row0 + ai * HALF + m * 16;
                    const u32x4 uw = *(const u32x4*)(AX + ((size_t)(u.bz * NCHP + chunk) * KEXT + i * 16 + j0)); float uf[8]; unpack8(uw, uf);
                    const f32x4 v0 = acc[ai][bj][m][0], v1 = acc[ai][bj][m][1]; float o[8];
#pragma unroll
                    for (int e = 0; e < 4; ++e) { o[e] = gelu_tanh(v0[e] + d0[e] * uf[e]); o[4 + e] = gelu_tanh(v1[e] + d1[e] * uf[4 + e]); }
                    *(u32x4*)(SG + ((size_t)(chunk * LCH + i) * 512 + ch)) = pack8(o); } }
    } };
struct EpiGlu { static constexpr bool PERM = true; const bf16_t* SG; const float* gout; bf16_t* MG;
    __device__ __forceinline__ void operator()(EPI_ARGS) const {
        const int row0 = u.pm * BM + wr * 64 + fr, colb = u.pn * BM + wc * 32 + 8 * fq;
#pragma unroll
        for (int bj = 0; bj < 2; ++bj) { const int c = colb + bj * HALF;
            const f32x4 g0 = *(const f32x4*)(gout + c), g1 = *(const f32x4*)(gout + c + 4);
#pragma unroll
            for (int ai = 0; ai < 2; ++ai)
#pragma unroll
                for (int m = 0; m < 4; ++m) { const int row = row0 + ai * HALF + m * 16;
                    const u32x4 sw = *(const u32x4*)(SG + (size_t)row * 512 + c); float sf[8]; unpack8(sw, sf);
                    const f32x4 v0 = acc[ai][bj][m][0], v1 = acc[ai][bj][m][1]; float o[8]; float ss = 0.f;
#pragma unroll
                    for (int e = 0; e < 4; ++e) { o[e] = sf[e] * sigmoidf_(v0[e]); o[4 + e] = sf[4 + e] * sigmoidf_(v1[e]); ss += o[e] * o[e] + o[4 + e] * o[4 + e]; }
                    ss += __shfl_xor(ss, 16);
                    const float rs = 1.0f / sqrtf(ss * (1.0f / 16.0f) + EPS);
#pragma unroll
                    for (int e = 0; e < 4; ++e) { o[e] = o[e] * rs * g0[e]; o[4 + e] = o[4 + e] * rs * g1[e]; }
                    *(u32x4*)(MG + (size_t)row * D + 512 + c) = pack8(o); } }
    } };
struct EpiOut { static constexpr bool PERM = false; const float* X; const float* gate; float* OUT;
    __device__ __forceinline__ void operator()(EPI_ARGS) const {
        const int row0 = u.pm * BM + wr * 64 + fr, col0 = u.pn * BM + wc * 32 + 4 * fq;
        f32x4 gv[2][2];
#pragma unroll
        for (int bj = 0; bj < 2; ++bj)
#pragma unroll
            for (int n = 0; n < 2; ++n) gv[bj][n] = *(const f32x4*)(gate + col0 + bj * HALF + n * 16);
#pragma unroll
        for (int ai = 0; ai < 2; ++ai)
#pragma unroll
            for (int m = 0; m < 4; ++m) { const size_t off = (size_t)(row0 + ai * HALF + m * 16) * D + col0;
#pragma unroll
                for (int bj = 0; bj < 2; ++bj)
#pragma unroll
                    for (int n = 0; n < 2; ++n) { const f32x4 xv = *(const f32x4*)(X + off + bj * HALF + n * 16); *(f32x4*)(OUT + off + bj * HALF + n * 16) = xv + gv[bj][n] * acc[ai][bj][m][n]; }
                asm volatile("" ::: "memory"); }
    } };
struct EpiMlp1 { static constexpr bool PERM = true; bf16_t* H;
    __device__ __forceinline__ void operator()(EPI_ARGS) const {
        const int row0 = u.pm * BM + wr * 64 + fr, colb = u.pn * BM + wc * 32 + 8 * fq;
#pragma unroll
        for (int ai = 0; ai < 2; ++ai)
#pragma unroll
            for (int m = 0; m < 4; ++m) { bf16_t* rowp = H + (size_t)(row0 + ai * HALF + m * 16) * FF + colb;
#pragma unroll
                for (int bj = 0; bj < 2; ++bj) { f32x4 v0 = acc[ai][bj][m][0], v1 = acc[ai][bj][m][1];
#pragma unroll
                    for (int e = 0; e < 4; ++e) { const float a = fmaxf(v0[e], 0.f), b = fmaxf(v1[e], 0.f); v0[e] = a * a; v1[e] = b * b; }
                    u32x4 w; w.x = pk2(v0[0], v0[1]); w.y = pk2(v0[2], v0[3]); w.z = pk2(v1[0], v1[1]); w.w = pk2(v1[2], v1[3]);
                    *(u32x4*)(rowp + bj * HALF) = w; } }
    } };
}

#define XB_TMO      128
#define XB_XCNT(j)  (256  + 64 * (j))
#define XB_XSUB(j)  (1280 + 64 * (j))
#define XB_XGEN(j)  (2304 + 64 * (j))
#define XB_TOP      3328
#define XB_TOPGEN   3392
#define XCD_BAR_WORDS 3456
#define XB_SPIN_CAP (1u << 18)
__device__ __forceinline__ unsigned xb_ld(unsigned* p)              { return __hip_atomic_load(p, __ATOMIC_RELAXED, __HIP_MEMORY_SCOPE_AGENT); }
__device__ __forceinline__ unsigned xb_add(unsigned* p, unsigned v) { return __hip_atomic_fetch_add(p, v, __ATOMIC_RELAXED, __HIP_MEMORY_SCOPE_AGENT); }
__device__ __forceinline__ unsigned xb_xcc_id() { return (unsigned)__builtin_amdgcn_s_getreg((3 << 11) | 20) & 0xFu; }
#define XB_SPIN(cond, bar) do { unsigned _sp = 0; while (cond) { __builtin_amdgcn_s_sleep(1); \
    if ((++_sp & 255u) == 0u) { if (xb_ld(&(bar)[XB_TMO])) break; if (_sp > XB_SPIN_CAP) { atomicAdd(&(bar)[XB_TMO], 1u); break; } } } } while (0)
struct XcdBarrier { unsigned* bar; unsigned x; volatile LAS unsigned* st; };
__device__ __forceinline__ XcdBarrier xcd_barrier_post(unsigned* bar, volatile LAS unsigned* st) {
    XcdBarrier b; b.bar = bar; b.x = xb_xcc_id(); b.st = st;
    if (threadIdx.x == 0) (void)xb_add(&bar[XB_XCNT(b.x)], 1u);
    return b; }
__device__ __forceinline__ void xcd_barrier_complete(unsigned* bar, unsigned x, unsigned& nloc, unsigned& nx) {
    const unsigned G = gridDim.x * gridDim.y * gridDim.z;
    unsigned sum, cnt, mine, sp = 0u;
    for (;;) {
        sum = 0u; cnt = 0u; mine = 0u;
#pragma unroll
        for (unsigned j = 0; j < 16; ++j) { const unsigned c = xb_ld(&bar[XB_XCNT(j)]); sum += c; cnt += (c > 0u) ? 1u : 0u; mine = (j == x) ? c : mine; }
        if (sum == G) break;
        __builtin_amdgcn_s_sleep(1);
        if ((++sp & 255u) == 0u) { if (xb_ld(&bar[XB_TMO])) break; if (sp > XB_SPIN_CAP) { atomicAdd(&bar[XB_TMO], 1u); break; } }
    }
    nloc = mine > 0u ? mine : 1u; nx = cnt > 0u ? cnt : 1u; }
__device__ __forceinline__ void xcd_barrier(const XcdBarrier& b) {
    asm volatile("s_waitcnt vmcnt(0)" ::: "memory");
    __syncthreads();
    if (threadIdx.x == 0) {
        unsigned* bar = b.bar;
        __builtin_amdgcn_s_waitcnt(0);
        unsigned nloc = b.st[0], nx = b.st[1];
        if (nloc == 0u) { xcd_barrier_complete(bar, b.x, nloc, nx); b.st[0] = nloc; b.st[1] = nx; }
        const unsigned old = xb_add(&bar[XB_XSUB(b.x)], 1u);
        const unsigned gen = old / nloc;
        if (old + 1u == (gen + 1u) * nloc) {
            __builtin_amdgcn_fence(__ATOMIC_RELEASE, "agent");
            asm volatile("s_waitcnt vmcnt(0)" ::: "memory");
            const unsigned og = xb_add(&bar[XB_TOP], 1u);
            const unsigned tg = og / nx;
            if (og + 1u == (tg + 1u) * nx) xb_add(&bar[XB_TOPGEN], 1u);
            else XB_SPIN(xb_ld(&bar[XB_TOPGEN]) == tg, bar);
            __builtin_amdgcn_fence(__ATOMIC_ACQUIRE, "agent");
            xb_add(&bar[XB_XGEN(b.x)], 1u);
            asm volatile("s_waitcnt vmcnt(0)" ::: "memory");
        } else {
            XB_SPIN(xb_ld(&bar[XB_XGEN(b.x)]) == gen, bar);
            __builtin_amdgcn_fence(__ATOMIC_ACQUIRE, "agent");
            asm volatile("s_waitcnt vmcnt(0)" ::: "memory");
        }
    }
    __syncthreads(); }

struct Args {
    const float *x, *c, *ctx, *c_ctx, *w_mod, *b_mod, *g_norm1, *w_in, *conv_w, *a_re, *a_im, *log_dt, *b_re, *b_im, *c_re, *c_im, *ssm_d, *w_glu, *g_conv_out, *g_ssm_out,
        *w_out, *g_norm2, *w_mlp1, *w_mlp2, *g_final;
    float* out; unsigned char* ws;
};

__device__ __forceinline__ void transpose_item(const float* W, int K, int N, bf16_t* WT, LAS float* scr, int item, int lane) {
    const int nblk = N / 32, kb = item / nblk, nb = item % nblk, k0 = 64 * kb, n0 = 32 * nb;
    float tv[32];
#pragma unroll
    for (int i = 0; i < 32; ++i) tv[i] = W[(size_t)(k0 + 2 * i + (lane >> 5)) * N + n0 + (lane & 31)];
#pragma unroll
    for (int i = 0; i < 32; ++i) scr[(2 * i + (lane >> 5)) * 33 + (lane & 31)] = tv[i];
    asm volatile("s_waitcnt lgkmcnt(0)" ::: "memory");
    const int cc = lane & 7;
#pragma unroll
    for (int j = 0; j < 4; ++j) { const int n = (lane >> 3) + 8 * j; const LAS float* s = scr + (8 * cc) * 33 + n;
        u32x4 o; o.x = pk2(s[0 * 33], s[1 * 33]); o.y = pk2(s[2 * 33], s[3 * 33]); o.z = pk2(s[4 * 33], s[5 * 33]); o.w = pk2(s[6 * 33], s[7 * 33]);
        *(u32x4*)(WT + (size_t)(n0 + n) * K + k0 + 8 * cc) = o; }
    asm volatile("s_waitcnt lgkmcnt(0)" ::: "memory");
}

__device__ __forceinline__ void zoh_params(const Args& A, int d, int g, int p, double& lr, double& li, double& dt) {
    const int gi = (d * NG + g) * 64 + p;
    lr = (double)fminf(A.a_re[gi], -1e-4f); li = (double)A.a_im[gi]; dt = (double)expf(A.log_dt[d * NG + g]); }

__device__ __forceinline__ void prep_ssm_item(const Args& A, LAS float* L, int it, int tid, bf16_t* BEXT, bf16_t* MS) {
    const int g = it >> 3, kq = it & 7;
    LAS float* pwr = L; LAS float* pwi = L + 4224; LAS float* bbr = L + 8448; LAS float* bbi = L + 10496; LAS float* kt = L + 12544;
    LAS float* zp = L + 20736;
    if (tid < 128) { double lr, li, dt; zoh_params(A, tid >> 6, g, tid & 63, lr, li, dt); zp[tid * 3] = (float)lr; zp[tid * 3 + 1] = (float)li; zp[tid * 3 + 2] = (float)dt; }
    __syncthreads();
    for (int idx = tid; idx < 4224; idx += 512) {
        const int d = idx / 2112, rem = idx % 2112, p = rem / 33, k = rem % 33;
        const double lr = (double)zp[(d * 64 + p) * 3], li = (double)zp[(d * 64 + p) * 3 + 1], dt = (double)zp[(d * 64 + p) * 3 + 2];
        const float mag = expf((float)((double)k * lr * dt));
        double s, c; sincos_rev((double)k * li * dt * 0.15915494309189533577, s, c);
        pwr[idx] = mag * (float)c; pwi[idx] = mag * (float)s; }
    if (tid < 128) { const int d = tid >> 6, p = tid & 63, gi = (d * NG + g) * 64 + p;
        double lr, li, dt; zoh_params(A, d, g, p, lr, li, dt);
        const double mag = (double)expf((float)(lr * dt)); double s, c; sincos_rev(li * dt * 0.15915494309189533577, s, c);
        const double abr = mag * c, abi = mag * s, nr = abr - 1.0, den = lr * lr + li * li;
        const float fr_ = (float)((nr * lr + abi * li) / den), fi_ = (float)((abi * lr - nr * li) / den);
        const float* Br = A.b_re + (size_t)gi * 16; const float* Bi = A.b_im + (size_t)gi * 16;
#pragma unroll
        for (int j = 0; j < 16; ++j) { const float br = Br[j], bi = Bi[j]; bbr[(d * 64 + p) * 16 + j] = fr_ * br - fi_ * bi; bbi[(d * 64 + p) * 16 + j] = fr_ * bi + fi_ * br; } }
    __syncthreads();
    { const int pq = tid >> 7, t = tid & 127, d = t >> 6, kk = (t >> 4) & 3, jo = t & 15, k = kq * 4 + kk;
        float a[16];
#pragma unroll
        for (int j = 0; j < 16; ++j) a[j] = 0.f;
        const float* Cr = A.c_re + ((size_t)(d * NG + g) * 16 + jo) * 64; const float* Ci = A.c_im + ((size_t)(d * NG + g) * 16 + jo) * 64;
        for (int pp = 0; pp < 16; ++pp) { const int p = pq * 16 + pp; const float cr = Cr[p], ci = Ci[p], ar = pwr[(d * 64 + p) * 33 + k], ai = pwi[(d * 64 + p) * 33 + k];
            const float car = cr * ar - ci * ai, cai = cr * ai + ci * ar;
#pragma unroll
            for (int j = 0; j < 16; ++j) a[j] += car * bbr[(d * 64 + p) * 16 + j] - cai * bbi[(d * 64 + p) * 16 + j]; }
#pragma unroll
        for (int j = 0; j < 16; ++j) kt[((pq * 2 + d) * 4 + kk) * 256 + jo * 16 + j] = a[j]; }
    __syncthreads();
    bf16_t* Bg = BEXT + (size_t)g * 512 * KEXT;
    for (int idx = tid; idx < 8192; idx += 512) {
        const int hf = idx & 1, jo = (idx >> 1) & 15, pos = (idx >> 5) & 31, kk = (idx >> 10) & 3, d = idx >> 12, k = kq * 4 + kk;
        if (pos >= 32 - k || (k == 0 && d == 1)) continue;
        const int i = d == 0 ? pos + k : pos, s = d == 0 ? pos : pos + k;
        float v[8];
#pragma unroll
        for (int e = 0; e < 8; ++e) { const int ji = hf * 8 + e; float a = 0.f;
#pragma unroll
            for (int pq = 0; pq < 4; ++pq) { a += kt[((pq * 2 + d) * 4 + kk) * 256 + jo * 16 + ji]; if (k == 0) a += kt[((pq * 2 + 1) * 4 + kk) * 256 + jo * 16 + ji]; }
            v[e] = a; }
        *(u32x4*)(Bg + (size_t)(i * 16 + jo) * KEXT + s * 16 + hf * 8) = pack8(v); }
    for (int idx = tid; idx < 2048; idx += 512) {
        const int pp = idx & 7, ri = (idx >> 3) & 1, d = (idx >> 4) & 1, jo = (idx >> 5) & 15, ii = idx >> 9;
        const int i = kq * 4 + ii, kp = d == 0 ? i + 1 : 32 - i;
        const float* Cr = A.c_re + ((size_t)(d * NG + g) * 16 + jo) * 64 + pp * 8; const float* Ci = A.c_im + ((size_t)(d * NG + g) * 16 + jo) * 64 + pp * 8;
        float v[8];
#pragma unroll
        for (int e = 0; e < 8; ++e) { const int p = pp * 8 + e; const float cr = Cr[e], ci = Ci[e], ar = pwr[(d * 64 + p) * 33 + kp], ai = pwi[(d * 64 + p) * 33 + kp];
            v[e] = ri == 0 ? (cr * ar - ci * ai) : -(cr * ai + ci * ar); }
        *(u32x4*)(Bg + (size_t)(i * 16 + jo) * KEXT + 512 + d * 128 + ri * 64 + pp * 8) = pack8(v); }
    bf16_t* Mg = MS + (size_t)g * 256 * 512;
    for (int idx = tid; idx < 2048; idx += 512) {
        const int hf = idx & 1, ss = (idx >> 1) & 3, p = (idx >> 3) & 63, ri = (idx >> 9) & 1, d = idx >> 10;
        const int s = kq * 4 + ss, kp = d == 0 ? 31 - s : s;
        const float ar = pwr[(d * 64 + p) * 33 + kp], ai = pwi[(d * 64 + p) * 33 + kp];
        float v[8];
#pragma unroll
        for (int e = 0; e < 8; ++e) { const int ji = hf * 8 + e; const float br = bbr[(d * 64 + p) * 16 + ji], bi = bbi[(d * 64 + p) * 16 + ji];
            v[e] = ri == 0 ? (ar * br - ai * bi) : (ar * bi + ai * br); }
        *(u32x4*)(Mg + (size_t)(d * 128 + ri * 64 + p) * 512 + s * 16 + hf * 8) = pack8(v); }
    __syncthreads();
}

__device__ __forceinline__ void row_norm_mod(const float* src, bf16_t* dst, const float* gv, const float* sc, const float* sh, int lane) {
    f32x4 v[4]; float s = 0.f;
#pragma unroll
    for (int j = 0; j < 4; ++j) { v[j] = ((const f32x4*)src)[lane + 64 * j]; s += (v[j][0] * v[j][0] + v[j][1] * v[j][1]) + (v[j][2] * v[j][2] + v[j][3] * v[j][3]); }
    const float rstd = 1.0f / sqrtf(wave_sum(s) * (1.0f / D) + EPS);
#pragma unroll
    for (int j = 0; j < 4; ++j) { const int k4 = lane + 64 * j; const f32x4 g = ((const f32x4*)gv)[k4], c = ((const f32x4*)sc)[k4], h = ((const f32x4*)sh)[k4];
        const f32x4 o = v[j] * rstd * g * (1.0f + c) + h; u32x2 w; w.x = pk2(o[0], o[1]); w.y = pk2(o[2], o[3]); ((u32x2*)dst)[k4] = w; }
}

__device__ __forceinline__ void row_norm_mod2(const float* src0, const float* src1, bf16_t* dst0, bf16_t* dst1, const float* gv, const float* sc, const float* sh, int lane) {
    f32x4 v[4], w[4]; float s = 0.f, t = 0.f;
#pragma unroll
    for (int j = 0; j < 4; ++j) { v[j] = ((const f32x4*)src0)[lane + 64 * j]; w[j] = ((const f32x4*)src1)[lane + 64 * j]; }
#pragma unroll
    for (int j = 0; j < 4; ++j) { s += (v[j][0] * v[j][0] + v[j][1] * v[j][1]) + (v[j][2] * v[j][2] + v[j][3] * v[j][3]); t += (w[j][0] * w[j][0] + w[j][1] * w[j][1]) + (w[j][2] * w[j][2] + w[j][3] * w[j][3]); }
#pragma unroll
    for (int o = 1; o < 64; o <<= 1) { s += __shfl_xor(s, o); t += __shfl_xor(t, o); }
    const float r0 = 1.0f / sqrtf(s * (1.0f / D) + EPS), r1 = 1.0f / sqrtf(t * (1.0f / D) + EPS);
#pragma unroll
    for (int j = 0; j < 4; ++j) { const int k4 = lane + 64 * j; const f32x4 g = ((const f32x4*)gv)[k4], c = ((const f32x4*)sc)[k4], h = ((const f32x4*)sh)[k4]; const f32x4 gs = g * (1.0f + c);
        const f32x4 o = v[j] * r0 * gs + h, q = w[j] * r1 * gs + h; u32x2 a, b; a.x = pk2(o[0], o[1]); a.y = pk2(o[2], o[3]); b.x = pk2(q[0], q[1]); b.y = pk2(q[2], q[3]);
        ((u32x2*)dst0)[k4] = a; ((u32x2*)dst1)[k4] = b; }
}
__device__ __forceinline__ void late_transpose_item(const Args& A, unsigned char* ws, LAS float* scr, int it, int lane) {
    int r = it;
    if (r < 128) { transpose_item(A.w_glu, 512, 512, (bf16_t*)(ws + WS_WGLU), scr, r, lane); return; } r -= 128;
    if (r < 512) { transpose_item(A.w_out, 1024, 1024, (bf16_t*)(ws + WS_WOUT), scr, r, lane); return; } r -= 512;
    if (r < 2048) { transpose_item(A.w_mlp1, 1024, 4096, (bf16_t*)(ws + WS_W1), scr, r, lane); return; } r -= 2048;
    transpose_item(A.w_mlp2, 4096, 1024, (bf16_t*)(ws + WS_W2), scr, r, lane);
}
constexpr int LATE_ITEMS = 4736, LATE_P2 = 3040;

__device__ __forceinline__ int fresh_tid() { int t = threadIdx.x; asm volatile("" : "+v"(t)); return t; }
__global__ void __launch_bounds__(512, 2) hybrid_fwd(Args A) {
    extern __shared__ __attribute__((aligned(16))) unsigned char lds_raw[];
    LAS unsigned char* lds = (LAS unsigned char*)lds_raw;
    const int G = gridDim.x, bid = blockIdx.x, NGW = G * 8;
#define PHASE_IDS const int tid = fresh_tid(), lane = tid & 63, wave = __builtin_amdgcn_readfirstlane(tid >> 6), gw = bid * 8 + wave; (void)gw; (void)lane
    unsigned char* ws = A.ws;
    float* MOD = (float*)(ws + WS_MOD); float* MODC = MOD + 6144;
    bf16_t* WIN = (bf16_t*)(ws + WS_WIN); bf16_t* WGLU = (bf16_t*)(ws + WS_WGLU); bf16_t* WOUT = (bf16_t*)(ws + WS_WOUT); bf16_t* W1 = (bf16_t*)(ws + WS_W1); bf16_t* W2 = (bf16_t*)(ws + WS_W2);
    bf16_t* HB = (bf16_t*)(ws + WS_H); bf16_t* BEXT = (bf16_t*)(ws + WS_BEXT); bf16_t* MS = (bf16_t*)(ws + WS_MS); bf16_t* AX = (bf16_t*)(ws + WS_AX);
    float* SB = (float*)(ws + WS_SB); bf16_t* SG = (bf16_t*)(ws + WS_SG); bf16_t* Z = (bf16_t*)(ws + WS_Z); bf16_t* XN = (bf16_t*)(ws + WS_XN); bf16_t* MG = (bf16_t*)(ws + WS_MG);

    if (threadIdx.x < 64) ((LAS unsigned*)(lds + 131072))[threadIdx.x] = 0u;
    __syncthreads();
    const XcdBarrier bar = xcd_barrier_post((unsigned*)(ws + WS_CTL), (volatile LAS unsigned*)(lds + 131072 + 64));
#define GRID_BAR() xcd_barrier(bar)
    { PHASE_IDS;
        LAS float* L = (LAS float*)lds;
        const int ngemv = (G > 192) ? 192 : 0;
        if (ngemv == 0 || bid < 192) {
            for (int it = bid; it < 192; it += (ngemv ? 192 : G)) {
                for (int k = tid; k < 1024; k += 512) { const float v = A.c[k]; L[k] = v / (1.0f + expf(-v)); const float w = A.c_ctx[k]; L[1024 + k] = w / (1.0f + expf(-w)); }
                __syncthreads();
                const int n = it * 32 + (lane & 31), half = lane >> 5; float a = 0.f, b = 0.f;
                const float* wp = A.w_mod + (size_t)(wave * 128 + half) * 6144 + n;
#pragma unroll
                for (int h4 = 0; h4 < 2; ++h4) { float wv[32];
#pragma unroll
                    for (int kk = 0; kk < 32; ++kk) wv[kk] = wp[(size_t)(2 * (h4 * 32 + kk)) * 6144];
#pragma unroll
                    for (int kk = 0; kk < 32; ++kk) { const int k = wave * 128 + 2 * (h4 * 32 + kk) + half; a += L[k] * wv[kk]; b += L[1024 + k] * wv[kk]; } }
                a += __shfl_xor(a, 32); b += __shfl_xor(b, 32);
                if (lane < 32) { L[2048 + wave * 64 + lane] = a; L[2048 + wave * 64 + 32 + lane] = b; }
                __syncthreads();
                if (tid < 64) { float s = 0.f;
#pragma unroll
                    for (int w = 0; w < 8; ++w) s += L[2048 + w * 64 + tid];
                    const int nn = it * 32 + (tid & 31); s += A.b_mod[nn]; if (tid < 32) MOD[nn] = s; else MODC[nn] = s; }
                __syncthreads();
            }
        }
        if (ngemv == 0 || bid >= 192) {
            LAS float* scr = (LAS float*)(lds + wave * 16384);
            const int tw = (bid - ngemv) * 8 + wave, NTW = (G - ngemv) * 8;
            for (int it = tw; it < 1024; it += NTW) transpose_item(A.w_in, 1024, 2048, WIN, scr, it, lane);
        }
    }
    GRID_BAR();
    { PHASE_IDS;
        for (int r = gw; r < SEQ; r += 2 * NGW) {
            if (r + NGW < SEQ) row_norm_mod2(A.x + (size_t)r * D, A.x + (size_t)(r + NGW) * D, XN + (size_t)r * D, XN + (size_t)(r + NGW) * D, A.g_norm1, MOD + 1024, MOD, lane);
            else row_norm_mod(A.x + (size_t)r * D, XN + (size_t)r * D, A.g_norm1, MOD + 1024, MOD, lane); }
        for (int r = gw; r < CTX; r += NGW) row_norm_mod(A.ctx + (size_t)r * D, XN + (size_t)(SEQ + r) * D, A.g_norm1, MODC + 1024, MODC, lane);
        for (int it = bid; it < 256; it += G) prep_ssm_item(A, (LAS float*)lds, it, tid, BEXT, MS);
    }
    GRID_BAR();
    { pg8::Gemm g{XN, WIN, 1024, 1024, 1024}; pg8::Order S; S.init(64, 8, 1, 1024, 1024, 0, 0, G, bid);
      pg8::EpiZ E{Z, AX}; pg8::gemm_phase(lds, g, S, E); }
    GRID_BAR();
    if (bid < 64) {
        pg8::Gemm g{AX, MS, 512, KEXT, 512}; pg8::Order S; S.init(2, 1, NG, KEXT, 512, (size_t)NCHP * KEXT * 2, (size_t)256 * 512 * 2, 64, bid);
        pg8::EpiS1 E{SB}; pg8::gemm_phase(lds, g, S, E);
    } else if (bid < 66) {
        const int b = bid - 64;
        pg8::Gemm g{XN, WIN, 1024, 1024, 1024}; pg8::OrderOne S; S.one.pm = 64; S.one.pn = 6 + b; S.one.bz = 0;
        S.one.aoff = (size_t)64 * 256 * 1024 * 2; S.one.boff = (size_t)(6 + b) * 256 * 1024 * 2;
        pg8::EpiZ E{Z, AX}; pg8::gemm_phase(lds, g, S, E);
    } else { PHASE_IDS;
        LAS float* scr = (LAS float*)(lds + wave * 16384);
        for (int it = (bid - 66) * 8 + wave; it < LATE_P2; it += (G - 66) * 8) late_transpose_item(A, ws, scr, it, lane);
    }
    GRID_BAR();
    { PHASE_IDS;
        const int nscan = (G > 64) ? 64 : 0;
        if (nscan == 0 || bid < 64) {
            LAS float* T = (LAS float*)lds;
            for (int it = bid; it < 64; it += (nscan ? 64 : G)) {
                const int g = it >> 1, d = it & 1, p = lane;
                double lr, li, dt; zoh_params(A, d, g, p, lr, li, dt);
                double sn, cs;
                const float magL = expf((float)(32.0 * lr * dt)); sincos_rev(32.0 * li * dt * 0.15915494309189533577, sn, cs);
                const float aLr = magL * (float)cs, aLi = magL * (float)sn;
                const float magS = expf((float)(2048.0 * lr * dt)); sincos_rev(2048.0 * li * dt * 0.15915494309189533577, sn, cs);
                const float aSr = magS * (float)cs, aSi = magS * (float)sn;
                const float* Sg = SB + (size_t)g * NCHP * 256 + d * 128 + p;
                bf16_t* Hg = AX + (size_t)g * NCHP * KEXT + 512 + d * 128 + p;
                float sr[64], si[64];
                const int c_first = d == 0 ? wave * 64 : NCH - 1 - wave * 64; const long cst = d == 0 ? 1 : -1;
                { const float* qp = Sg + (size_t)c_first * 256;
#pragma unroll
                  for (int e = 0; e < 64; ++e) { sr[e] = qp[0]; si[e] = qp[64]; qp += cst * 256; asm volatile("" : "+v"(qp)); } }
                {
                    LAS float* U = T + 1024 + wave * 512;
                    { const u32x4 uw = *(const u32x4*)(AX + ((size_t)(g * NCHP + NCH + wave) * KEXT + lane * 8)); float uf[8]; unpack8(uw, uf);
#pragma unroll
                      for (int e = 0; e < 8; ++e) U[lane * 8 + e] = uf[e]; }
                    asm volatile("s_waitcnt lgkmcnt(0)" ::: "memory");
                    const bf16_t* mr = MS + ((size_t)g * 256 + d * 128 + p) * 512; const bf16_t* mi = mr + 64 * 512;
                    float xr = 0.f, xi = 0.f;
#pragma unroll 4
                    for (int k8 = 0; k8 < 64; ++k8) { float a[8], b[8]; unpack8(*(const u32x4*)(mr + k8 * 8), a); unpack8(*(const u32x4*)(mi + k8 * 8), b);
#pragma unroll
                        for (int e = 0; e < 8; ++e) { const float uu = U[k8 * 8 + e]; xr += a[e] * uu; xi += b[e] * uu; } }
                    T[6144 + (wave * 64 + p) * 2] = xr; T[6144 + (wave * 64 + p) * 2 + 1] = xi;
                }
                __syncthreads();
                float hr = 0.f, hi = 0.f;
                if (wave == 0) {
#pragma unroll
                    for (int q = 0; q < 8; ++q) { const int cc = d == 0 ? q : 7 - q; const float xr = T[6144 + (cc * 64 + p) * 2], xi = T[6144 + (cc * 64 + p) * 2 + 1];
                        const float nr = aLr * hr - aLi * hi + xr, ni = aLr * hi + aLi * hr + xi; hr = nr; hi = ni; }
                }
                float cr = hr, ci = hi;
#pragma unroll
                for (int e = 0; e < 64; ++e) { const float nr = aLr * hr - aLi * hi + sr[e], ni = aLr * hi + aLi * hr + si[e]; hr = nr; hi = ni; }
                T[(wave * 64 + p) * 2] = hr; T[(wave * 64 + p) * 2 + 1] = hi;
                __syncthreads();
                if (wave > 0) { float er = T[p * 2], ei = T[p * 2 + 1];
                    for (int v = 1; v < wave; ++v) { const float tr = T[(v * 64 + p) * 2], ti = T[(v * 64 + p) * 2 + 1]; const float nr = aSr * er - aSi * ei + tr, ni = aSr * ei + aSi * er + ti; er = nr; ei = ni; }
                    cr = er; ci = ei; }
                hr = cr; hi = ci;
                { bf16_t* hp = Hg + (size_t)c_first * KEXT;
#pragma unroll
                  for (int e = 0; e < 64; ++e) { hp[0] = (bf16_t)f2bf(hr); hp[64] = (bf16_t)f2bf(hi); hp += cst * KEXT; asm volatile("" : "+v"(hp));
                    const float nr = aLr * hr - aLi * hi + sr[e], ni = aLr * hi + aLi * hr + si[e]; hr = nr; hi = ni; } }
                __syncthreads();
            }
        }
        if (nscan == 0 || bid >= 64) {
            const int cw = (bid - nscan) * 8 + wave, NCW = (G - nscan) * 8;
            const int ch = lane * 8;
            float w0[8], w1[8], w2[8], gc[8];
#pragma unroll
            for (int e = 0; e < 8; ++e) { w0[e] = A.conv_w[ch + e]; w1[e] = A.conv_w[512 + ch + e]; w2[e] = A.conv_w[1024 + ch + e]; gc[e] = A.g_conv_out[ch + e]; }
            for (int t = cw; t < SEQ; t += NCW) {
                const bf16_t* zr = Z + (size_t)t * ZW + ch; const int col = t & 63;
                float b[8], c1[8], v1[8], cm[8], vm[8], cp[8], vp[8];
                unpack8(*(const u32x4*)zr, b); unpack8(*(const u32x4*)(zr + 512), c1); unpack8(*(const u32x4*)(zr + 1024), v1);
                const u32x4 zero = (u32x4){0u, 0u, 0u, 0u};
                unpack8(col > 0 ? *(const u32x4*)(zr - ZW + 512) : zero, cm); unpack8(col > 0 ? *(const u32x4*)(zr - ZW + 1024) : zero, vm);
                unpack8(col < 63 ? *(const u32x4*)(zr + ZW + 512) : zero, cp); unpack8(col < 63 ? *(const u32x4*)(zr + ZW + 1024) : zero, vp);
                float o[8]; float ss = 0.f;
#pragma unroll
                for (int e = 0; e < 8; ++e) { o[e] = b[e] * (w0[e] * cm[e] * vm[e] + w1[e] * c1[e] * v1[e] + w2[e] * cp[e] * vp[e]); ss += o[e] * o[e]; }
                ss += __shfl_xor(ss, 1); ss += __shfl_xor(ss, 2); ss += __shfl_xor(ss, 4);
                const float rs = 1.0f / sqrtf(ss * (1.0f / 64.0f) + EPS);
#pragma unroll
                for (int e = 0; e < 8; ++e) o[e] = o[e] * rs * gc[e];
                *(u32x4*)(MG + (size_t)t * D + ch) = pack8(o);
            }
        }
    }
    GRID_BAR();
    if (bid < 128) { pg8::Gemm g{AX, BEXT, KEXT, KEXT, KEXT}; pg8::Order S; S.init(2, 2, NG, KEXT, KEXT, (size_t)NCHP * KEXT * 2, (size_t)512 * KEXT * 2, 128, bid);
      pg8::EpiS3 E{AX, A.ssm_d, SG}; pg8::gemm_phase(lds, g, S, E); }
    else { PHASE_IDS; LAS float* scr = (LAS float*)(lds + wave * 16384);
      for (int it = LATE_P2 + (bid - 128) * 8 + wave; it < LATE_ITEMS; it += (G - 128) * 8) late_transpose_item(A, ws, scr, it, lane); }
    GRID_BAR();
    { pg8::Gemm g{SG, WGLU, 512, 512, 512}; pg8::Order S; S.init(64, 2, 1, 512, 512, 0, 0, G, bid);
      pg8::EpiGlu E{SG, A.g_ssm_out, MG}; pg8::gemm_phase(lds, g, S, E); }
    GRID_BAR();
    { pg8::Gemm g{MG, WOUT, 1024, 1024, 1024}; pg8::Order S; S.init(64, 4, 1, 1024, 1024, 0, 0, G, bid);
      pg8::EpiOut E{A.x, MOD + 2048, A.out}; pg8::gemm_phase(lds, g, S, E); }
    GRID_BAR();
    { PHASE_IDS; for (int r = gw; r < SEQ; r += NGW) row_norm_mod(A.out + (size_t)r * D, XN + (size_t)r * D, A.g_norm2, MOD + 4096, MOD + 3072, lane); }
    GRID_BAR();
    { pg8::Gemm g{XN, W1, 1024, 1024, 1024}; pg8::Order S; S.init(64, 16, 1, 1024, 1024, 0, 0, G, bid);
      pg8::EpiMlp1 E{HB}; pg8::gemm_phase(lds, g, S, E); }
    GRID_BAR();
    { pg8::Gemm g{HB, W2, 4096, 4096, 4096}; pg8::Order S; S.init(64, 4, 1, 4096, 4096, 0, 0, G, bid);
      pg8::EpiOut E{A.out, MOD + 5120, A.out}; pg8::gemm_phase(lds, g, S, E); }
    GRID_BAR();
    { PHASE_IDS; for (int r = gw; r < SEQ; r += NGW) {
        float* row = A.out + (size_t)r * D; f32x4 v[4]; float s = 0.f;
#pragma unroll
        for (int j = 0; j < 4; ++j) { v[j] = ((const f32x4*)row)[lane + 64 * j]; s += (v[j][0] * v[j][0] + v[j][1] * v[j][1]) + (v[j][2] * v[j][2] + v[j][3] * v[j][3]); }
        const float rstd = 1.0f / sqrtf(wave_sum(s) * (1.0f / D) + EPS);
#pragma unroll
        for (int j = 0; j < 4; ++j) { const f32x4 g = ((const f32x4*)A.g_final)[lane + 64 * j]; ((f32x4*)row)[lane + 64 * j] = v[j] * rstd * g; }
    } }
}

extern "C" void kernel_launch(void* const* d_in, const int* in_sizes, int n_in, void* d_out, int out_size, void* d_ws, size_t ws_size, hipStream_t stream) {
    static int grid_blocks = 0;
    if (grid_blocks == 0) {
        if (n_in != 25 || ws_size < WS_END) { fprintf(stderr, "kernel_launch: unexpected n_in %d / ws %zu\n", n_in, ws_size); grid_blocks = -1; return; }
        int dev = 0, cus = 0, per_cu = 0;
        (void)hipGetDevice(&dev); (void)hipDeviceGetAttribute(&cus, hipDeviceAttributeMultiprocessorCount, dev);
        (void)hipFuncSetAttribute((const void*)hybrid_fwd, hipFuncAttributeMaxDynamicSharedMemorySize, LDS_BYTES);
        (void)hipOccupancyMaxActiveBlocksPerMultiprocessor(&per_cu, (const void*)hybrid_fwd, 512, LDS_BYTES);
        if (per_cu < 1) { fprintf(stderr, "kernel_launch: occupancy query says %d blocks per CU\n", per_cu); per_cu = 1; }
        grid_blocks = cus * per_cu;
        if (grid_blocks < 136) { fprintf(stderr, "kernel_launch: grid %d too small\n", grid_blocks); grid_blocks = -1; return; }
    }
    if (grid_blocks < 0) return;
    if (hipMemsetAsync((char*)d_ws + WS_CTL, 0, CTL_BYTES, stream) != hipSuccess) { fprintf(stderr, "kernel_launch: memset failed\n"); return; }
    Args a{};
    const float** p = (const float**)&a;
    for (int i = 0; i < 25; ++i) p[i] = (const float*)d_in[i];
    a.out = (float*)d_out; a.ws = (unsigned char*)d_ws;
    void* args[] = {&a};
    hipError_t e = hipLaunchCooperativeKernel((const void*)hybrid_fwd, dim3(grid_blocks), dim3(512), args, LDS_BYTES, stream);
    if (e != hipSuccess) fprintf(stderr, "cooperative launch failed: %s (grid %d)\n", hipGetErrorString(e), grid_blocks);
}
```
